# Optimizing an MI355X kernel written in HIP

```python
import math
import jax, jax.numpy as jnp
from jax import lax
import numpy as np

D_MODEL = 2048
BATCH = 4
SEQ = 2048
DEPTH = 4

GRID_W = 64
CTX_LEN = 256
N_MIXERS = 3
N_MOD = 6
MLP_HIDDEN = 4 * D_MODEL
NORM_EPS = 1e-6
FNET_GROUPS = 8
FNET_GROUP_DIM = D_MODEL // FNET_GROUPS
HGRN_EXPAND = 128
HGRN_HEADS = D_MODEL // HGRN_EXPAND
HGRN_DK = HGRN_EXPAND
HGRN_DV = D_MODEL // HGRN_HEADS
HGRN_F = HGRN_HEADS * HGRN_DK
HGRN_CHUNK = 16
DIFF_HEAD_DIM = 128
DIFF_HEADS = D_MODEL // (2 * DIFF_HEAD_DIM)
DIFF_V_DIM = 2 * DIFF_HEAD_DIM
Q_BLOCK = 128
ROPE_BASE = 10000.0

kernel_name = 'hybrid_fnet_hgrn2_diffattn_dit'

F32 = jnp.float32


def rms_norm(x, g):
    xf = x.astype(F32)
    y = xf * lax.rsqrt(jnp.mean(xf * xf, axis=-1, keepdims=True) + NORM_EPS)
    return (y * g.astype(F32)).astype(x.dtype)


def modulate(h, shift, scale):
    return h * (1 + scale) + shift


def sqrelu_mlp(h, w1, w2):
    return jnp.square(jax.nn.relu(h @ w1)) @ w2


def axial_rope_tables(n_tokens, dim):
    rows = n_tokens // GRID_W
    row = jnp.broadcast_to(jnp.arange(rows)[:, None], (rows, GRID_W)).reshape(-1).astype(F32)
    col = jnp.broadcast_to(jnp.arange(GRID_W)[None, :], (rows, GRID_W)).reshape(-1).astype(F32)
    n_freq = dim // 4
    inv = ROPE_BASE ** (-jnp.arange(n_freq, dtype=F32) / n_freq)
    ang = jnp.concatenate([row[:, None] * inv, col[:, None] * inv], axis=-1)
    return jnp.cos(ang), jnp.sin(ang)


def apply_rope(x, cos, sin):
    xf = x.astype(F32)
    x1, x2 = jnp.split(xf, 2, axis=-1)
    return jnp.concatenate([x1 * cos - x2 * sin, x1 * sin + x2 * cos], axis=-1).astype(x.dtype)


def fourier_mix(h):
    B, L, D = h.shape
    hg = h.astype(F32).reshape(B, L, FNET_GROUPS, FNET_GROUP_DIM)
    return jnp.fft.fftn(hg, axes=(1, 3)).real.reshape(B, L, D).astype(h.dtype)


def hgrn_lower_bounds(p):
    cs = jnp.cumsum(jax.nn.softmax(p.astype(F32), axis=0), axis=0)
    return cs - cs[0:1]


def chunk_gla(q, k, v, logf, s0):
    B, H, L, dk = q.shape
    C = HGRN_CHUNK
    N = L // C
    r = lambda t: jnp.moveaxis(t.astype(F32).reshape(B, H, N, C, t.shape[-1]), 2, 0)
    bcum = jnp.cumsum(logf.astype(F32).reshape(B, H, N, C, dk), axis=3)
    xs = (r(q), r(k), r(v), jnp.moveaxis(bcum, 2, 0))
    mask = jnp.tril(jnp.ones((C, C), dtype=bool))[:, :, None]

    def step(s, inp):
        qc, kc, vc, bc = inp
        bl = bc[:, :, -1:, :]
        decay = jnp.exp(jnp.where(mask, bc[:, :, :, None, :] - bc[:, :, None, :, :], -jnp.inf))
        a = jnp.einsum('bhtd,bhsd,bhtsd->bhts', qc, kc, decay)
        o = jnp.einsum('bhts,bhsv->bhtv', a, vc) + jnp.einsum('bhtd,bhdv->bhtv', qc * jnp.exp(bc), s)
        s = jnp.exp(bl[:, :, 0, :])[..., None] * s + jnp.einsum('bhsd,bhsv->bhdv', kc * jnp.exp(bl - bc), vc)
        return s, o

    s_final, o = lax.scan(step, s0.astype(F32), xs)
    return jnp.moveaxis(o, 0, 2).reshape(B, H, L, v.shape[-1]), s_final


def hgrn2_mixer(h_lat, h_ctx, w_in, lb, gnorm, w_out, ctx_out):
    lb = lb.reshape(2, HGRN_HEADS, HGRN_DK)

    def project(h):
        B, L, _ = h.shape
        q, zf, zb, v, g = jnp.split(h @ w_in, [HGRN_F, 2 * HGRN_F, 3 * HGRN_F, 3 * HGRN_F + D_MODEL], axis=-1)
        hd = lambda t: t.reshape(B, L, HGRN_HEADS, -1).transpose(0, 2, 1, 3)
        return hd(q), hd(zf), hd(zb), hd(v), hd(g)

    def forget(z, lbd):
        zf = z.astype(F32)
        l = lbd[None, :, None, :]
        logf = jnp.logaddexp(jnp.log(l), jnp.log1p(-l) + jax.nn.log_sigmoid(zf))
        key = (1 - l) * jax.nn.sigmoid(-zf)
        return logf, key

    def readout(o, g, dtype):
        B, H, L, _ = o.shape
        y = rms_norm(o, gnorm) * jax.nn.silu(g.astype(F32))
        return y.transpose(0, 2, 1, 3).reshape(B, L, H * HGRN_DV).astype(dtype) @ w_out

    flip = lambda t: jnp.flip(t, axis=2)
    qc, zfc, zbc, vc, gc = project(h_ctx)
    ql, zfl, zbl, vl, gl = project(h_lat)
    s0 = jnp.zeros((qc.shape[0], HGRN_HEADS, HGRN_DK, HGRN_DV), F32)
    lfc, kfc = forget(zfc, lb[0])
    o_cf, s_f = chunk_gla(qc, kfc, vc, lfc, s0)
    lfl, kfl = forget(zfl, lb[0])
    o_lf, _ = chunk_gla(ql, kfl, vl, lfl, s_f)
    lbc, kbc = forget(zbc, lb[1])
    o_cb, s_b = chunk_gla(flip(qc), flip(kbc), flip(vc), flip(lbc), s0)
    lbl, kbl = forget(zbl, lb[1])
    o_lb, _ = chunk_gla(flip(ql), flip(kbl), flip(vl), flip(lbl), s_b)
    y_lat = readout(o_lf + flip(o_lb), gl, h_lat.dtype)
    y_ctx = readout(o_cf + flip(o_cb), gc, h_ctx.dtype) if ctx_out else None
    return y_lat, y_ctx


def diff_core(q, k, v, lam):
    s = jnp.einsum('bhmqd,bhmkd->bhmqk', q, k).astype(F32) * (DIFF_HEAD_DIM ** -0.5)
    p = jax.nn.softmax(s, axis=-1)
    a = p[:, :, 0] - lam * p[:, :, 1]
    return jnp.einsum('bhqk,bhkv->bhqv', a.astype(v.dtype), v)


def diff_attention(h_lat, h_ctx, w_qkv, lam_p, subln, w_out, lambda_init, cos, sin, ctx_out):
    def project(h):
        B, L, _ = h.shape
        q, k, v = jnp.split(h @ w_qkv, 3, axis=-1)
        q = q.reshape(B, L, DIFF_HEADS, 2, DIFF_HEAD_DIM).transpose(0, 2, 3, 1, 4)
        k = k.reshape(B, L, DIFF_HEADS, 2, DIFF_HEAD_DIM).transpose(0, 2, 3, 1, 4)
        v = v.reshape(B, L, DIFF_HEADS, DIFF_V_DIM).transpose(0, 2, 1, 3)
        return q, k, v

    def merge(o, dtype):
        B, H, L, _ = o.shape
        o = rms_norm(o, subln) * (1 - lambda_init)
        return o.transpose(0, 2, 1, 3).reshape(B, L, H * DIFF_V_DIM).astype(dtype) @ w_out

    lp = lam_p.astype(F32)
    lam = jnp.exp(jnp.sum(lp[0] * lp[1])) - jnp.exp(jnp.sum(lp[2] * lp[3])) + lambda_init
    q_c, k_c, v_c = project(h_ctx)
    q_l, k_l, v_l = project(h_lat)
    q_l, k_l = apply_rope(q_l, cos, sin), apply_rope(k_l, cos, sin)
    k_all = jnp.concatenate([k_c, k_l], axis=3)
    v_all = jnp.concatenate([v_c, v_l], axis=2)
    B, H, _, L, d = q_l.shape
    nb = L // Q_BLOCK
    q_blocks = jnp.moveaxis(q_l.reshape(B, H, 2, nb, Q_BLOCK, d), 3, 0)
    o_blocks = lax.map(lambda qb: diff_core(qb, k_all, v_all, lam), q_blocks)
    o_l = jnp.moveaxis(o_blocks, 0, 2).reshape(B, H, L, DIFF_V_DIM)
    y_lat = merge(o_l, h_lat.dtype)
    y_ctx = merge(diff_core(q_c, k_c, v_c, lam), h_ctx.dtype) if ctx_out else None
    return y_lat, y_ctx


def setup_inputs(seed: int = 0) -> dict:
    key = jax.random.key(seed)
    ks = jax.random.split(key, 20)
    n_slot = lambda m: len(range(m, DEPTH, N_MIXERS))
    n_a, n_b, n_c = n_slot(0), n_slot(1), n_slot(2)
    D = D_MODEL
    nrm = lambda k, shape, s: jax.random.normal(k, shape, F32) * s
    return {
        'x': nrm(ks[0], (BATCH, SEQ, D), 1.0),
        'c': nrm(ks[1], (BATCH, D), 1.0),
        'ctx': nrm(ks[2], (BATCH, CTX_LEN, D), 1.0),
        'c_ctx': nrm(ks[3], (D,), 1.0),
        'w_mod': nrm(ks[4], (DEPTH, D, N_MOD * D), D ** -0.5),
        'b_mod': nrm(ks[5], (DEPTH, N_MOD * D), 0.01),
        'norm_g': 1.0 + nrm(ks[6], (DEPTH, 4, D), 0.02),
        'w_mlp_in': nrm(ks[7], (DEPTH, D, MLP_HIDDEN), D ** -0.5),
        'w_mlp_out': nrm(ks[8], (DEPTH, MLP_HIDDEN, D), MLP_HIDDEN ** -0.5),
        'fnet_w_out': nrm(ks[9], (n_a, D, D), D ** -0.5),
        'hgrn_w_in': nrm(ks[10], (n_b, D, 3 * HGRN_F + 2 * D), D ** -0.5),
        'hgrn_lb': nrm(ks[11], (DEPTH, 2, HGRN_F), 0.1),
        'hgrn_gnorm': 1.0 + nrm(ks[12], (n_b, HGRN_DV), 0.02),
        'hgrn_w_out': nrm(ks[13], (n_b, D, D), D ** -0.5),
        'diff_w_qkv': nrm(ks[14], (n_c, D, 3 * D), D ** -0.5),
        'diff_lambda': nrm(ks[15], (n_c, 4, DIFF_HEAD_DIM), 0.1),
        'diff_subln': 1.0 + nrm(ks[16], (n_c, DIFF_V_DIM), 0.02),
        'diff_w_out': nrm(ks[17], (n_c, D, D), D ** -0.5),
    }


def reference(x, c, ctx, c_ctx, w_mod, b_mod, norm_g, w_mlp_in, w_mlp_out, fnet_w_out, hgrn_w_in, hgrn_lb, hgrn_gnorm, hgrn_w_out, diff_w_qkv, diff_lambda, diff_subln, diff_w_out):
    L = x.shape[1]
    cos, sin = axial_rope_tables(L, DIFF_HEAD_DIM)
    lower_bounds = hgrn_lower_bounds(hgrn_lb)
    silu_c = jax.nn.silu(c)
    silu_cc = jax.nn.silu(c_ctx)
    for i in range(DEPTH):
        mixer, slot = i % N_MIXERS, i // N_MIXERS
        ctx_out = i < DEPTH - 1
        ctx_in = ctx_out or mixer != 0
        sh1, sc1, g1, sh2, sc2, g2 = jnp.split((silu_c @ w_mod[i] + b_mod[i])[:, None, :], N_MOD, axis=-1)
        h_lat = modulate(rms_norm(x, norm_g[i, 0]), sh1, sc1)
        h_ctx = None
        if ctx_in:
            csh1, csc1, cg1, csh2, csc2, cg2 = jnp.split(silu_cc @ w_mod[i] + b_mod[i], N_MOD, axis=-1)
            h_ctx = modulate(rms_norm(ctx, norm_g[i, 0]), csh1, csc1)
        if mixer == 0:
            y_lat = fourier_mix(h_lat) @ fnet_w_out[slot]
            y_ctx = fourier_mix(h_ctx) @ fnet_w_out[slot] if ctx_out else None
        elif mixer == 1:
            y_lat, y_ctx = hgrn2_mixer(h_lat, h_ctx, hgrn_w_in[slot], lower_bounds[i], hgrn_gnorm[slot], hgrn_w_out[slot], ctx_out)
        else:
            lambda_init = 0.8 - 0.6 * math.exp(-0.3 * i)
            y_lat, y_ctx = diff_attention(h_lat, h_ctx, diff_w_qkv[slot], diff_lambda[slot], diff_subln[slot], diff_w_out[slot], lambda_init, cos, sin, ctx_out)
        x = x + g1 * rms_norm(y_lat, norm_g[i, 1])
        x = x + g2 * rms_norm(sqrelu_mlp(modulate(rms_norm(x, norm_g[i, 2]), sh2, sc2), w_mlp_in[i], w_mlp_out[i]), norm_g[i, 3])
        if ctx_out:
            ctx = ctx + cg1 * rms_norm(y_ctx, norm_g[i, 1])
            ctx = ctx + cg2 * rms_norm(sqrelu_mlp(modulate(rms_norm(ctx, norm_g[i, 2]), csh2, csc2), w_mlp_in[i], w_mlp_out[i]), norm_g[i, 3])
    return x
```

```cpp
#include <hip/hip_runtime.h>
#include <cstdio>
#include <cstdint>

#ifndef MK_PER_PHASE
#define MK_PER_PHASE 0
#endif

#define LAS __attribute__((address_space(3)))
#define GAS __attribute__((address_space(1)))
typedef unsigned short bf16_t;
typedef short bf16x8 __attribute__((ext_vector_type(8)));
typedef short s16x4 __attribute__((ext_vector_type(4)));
typedef float f32x4 __attribute__((ext_vector_type(4)));
typedef float f32x2 __attribute__((ext_vector_type(2)));
typedef float f32x8 __attribute__((ext_vector_type(8)));
typedef float f32x16 __attribute__((ext_vector_type(16)));
typedef unsigned u32x4 __attribute__((ext_vector_type(4)));
typedef unsigned u32x2 __attribute__((ext_vector_type(2)));

constexpr int DM = 2048, NBATCH = 4, SEQ = 2048, CTXL = 256, TPB = SEQ + CTXL, NROW = NBATCH * TPB, DEPTH = 4, HID = 8192;
constexpr float NORM_EPS = 1e-6f;
constexpr int NWAVES = 8, NTHR = 512;

constexpr size_t MiB = 1u << 20;
constexpr size_t WS_CTL = 0, CTL_BYTES = 1 * MiB;
constexpr size_t WS_MOD = 1 * MiB;
constexpr size_t WS_LB = 2 * MiB;
constexpr size_t WS_ROPE = 2 * MiB + 64 * 1024;
constexpr size_t WS_CS = 4 * MiB;
constexpr size_t WS_CS256 = 20 * MiB;
constexpr size_t WS_CC = 22 * MiB;
constexpr size_t WS_W1T = 32 * MiB;
constexpr size_t WS_W2T = 160 * MiB;
constexpr size_t WS_FWO = 288 * MiB;
constexpr size_t WS_HWIN = 304 * MiB;
constexpr size_t WS_HWO = 344 * MiB;
constexpr size_t WS_DQKV = 352 * MiB;
constexpr size_t WS_DWO = 376 * MiB;
constexpr size_t WS_X = 384 * MiB;
constexpr size_t WS_H = 456 * MiB;
constexpr size_t WS_ACT = 492 * MiB;
constexpr size_t WS_YO = 528 * MiB;
constexpr size_t WS_SCR = 600 * MiB;
constexpr size_t WS_SLAB = 1112 * MiB;
constexpr size_t SLAB_BYTES = (size_t)NBATCH * CTXL * DM * 2;
constexpr size_t WS_END = 1176 * MiB;
constexpr size_t SC_U = WS_SCR;
constexpr size_t SC_HT = WS_SCR, SC_HTC = WS_SCR + 32 * MiB, SC_PQ = WS_SCR + 64 * MiB, SC_PQC = WS_SCR + 128 * MiB;
constexpr size_t SC_HQ = WS_SCR, SC_HV = WS_SCR + 36 * MiB, SC_HG = WS_SCR + 72 * MiB, SC_HK = WS_SCR + 108 * MiB, SC_HLF = WS_SCR + 180 * MiB, SC_HO = WS_SCR + 324 * MiB;
constexpr size_t SC_DQ = WS_SCR, SC_DK = WS_SCR + 36 * MiB, SC_DV = WS_SCR + 72 * MiB, SC_DO = WS_SCR + 108 * MiB;
constexpr size_t ACT_ELEMS = (size_t)NROW * DM;

constexpr int CW_BAR = 4096;
constexpr int LDS_BYTES = 147456;
constexpr int MISC_OFF = 131072 + 8192;

typedef __bf16 bf16x2_t __attribute__((ext_vector_type(2)));
__device__ __forceinline__ unsigned cvt_pk_bf16(float lo, float hi) { const f32x2 v = {lo, hi}; const bf16x2_t b = __builtin_convertvector(v, bf16x2_t); return __builtin_bit_cast(unsigned, b); }
__device__ __forceinline__ unsigned f2bf(float f) { unsigned u = __builtin_bit_cast(unsigned, f); return (u + 0x7fffu + ((u >> 16) & 1u)) >> 16; }
__device__ __forceinline__ float bf2f(unsigned b) { return __builtin_bit_cast(float, b << 16); }
__device__ __forceinline__ float wave_sum(float v) {
#pragma unroll
    for (int o = 1; o < 64; o <<= 1) v += __shfl_xor(v, o);
    return v;
}
#define LDS_WAIT() asm volatile("s_waitcnt lgkmcnt(0)" ::: "memory")
#define VM_WAIT() asm volatile("s_waitcnt vmcnt(0)" ::: "memory")

#define XB_TMO      128
#define XB_XCNT(j)  (256  + 64 * (j))
#define XB_XSUB(j)  (1280 + 64 * (j))
#define XB_XGEN(j)  (2304 + 64 * (j))
#define XB_TOP      3328
#define XB_TOPGEN   3392
#define XCD_BAR_WORDS 3456
#define XB_SPIN_CAP (1u << 20)
__device__ __forceinline__ unsigned xb_ld(unsigned* p)              { return __hip_atomic_load(p, __ATOMIC_RELAXED, __HIP_MEMORY_SCOPE_AGENT); }
__device__ __forceinline__ unsigned xb_add(unsigned* p, unsigned v) { return __hip_atomic_fetch_add(p, v, __ATOMIC_RELAXED, __HIP_MEMORY_SCOPE_AGENT); }
__device__ __forceinline__ unsigned xb_xcc_id() { return (unsigned)__builtin_amdgcn_s_getreg((3 << 11) | 20) & 0xFu; }
#define XB_SPIN(cond, bar) do { unsigned _sp = 0; while (cond) { __builtin_amdgcn_s_sleep(1); \
    if ((++_sp & 255u) == 0u) { if (xb_ld(&(bar)[XB_TMO])) break; if (_sp > XB_SPIN_CAP) { atomicAdd(&(bar)[XB_TMO], 1u); break; } } } } while (0)
struct XcdBarrier { unsigned* bar; unsigned x; volatile LAS unsigned* st; };
__device__ __forceinline__ XcdBarrier xcd_barrier_post(unsigned* bar, volatile LAS unsigned* st) {
    XcdBarrier b; b.bar = bar; b.x = xb_xcc_id(); b.st = st;
    if (threadIdx.x == 0) (void)xb_add(&bar[XB_XCNT(b.x)], 1u);
    return b;
}
__device__ __forceinline__ void xcd_barrier_complete(unsigned* bar, unsigned x, unsigned& nloc, unsigned& nx) {
    const unsigned G = gridDim.x * gridDim.y * gridDim.z;
    unsigned sum, cnt, mine, sp = 0u;
    for (;;) {
        sum = 0u; cnt = 0u; mine = 0u;
#pragma unroll
        for (unsigned j = 0; j < 16; ++j) { const unsigned c = xb_ld(&bar[XB_XCNT(j)]); sum += c; cnt += (c > 0u) ? 1u : 0u; mine = (j == x) ? c : mine; }
        if (sum == G) break;
        __builtin_amdgcn_s_sleep(1);
        if ((++sp & 255u) == 0u) { if (xb_ld(&bar[XB_TMO])) break; if (sp > XB_SPIN_CAP) { atomicAdd(&bar[XB_TMO], 1u); break; } }
    }
    nloc = mine > 0u ? mine : 1u; nx = cnt > 0u ? cnt : 1u;
}
__device__ __forceinline__ void xcd_barrier(const XcdBarrier& b) {
    asm volatile("s_waitcnt vmcnt(0)" ::: "memory");
    __syncthreads();
    if (threadIdx.x == 0) {
        unsigned* bar = b.bar;
        __builtin_amdgcn_s_waitcnt(0);
        unsigned nloc = b.st[0], nx = b.st[1];
        if (nloc == 0u) { xcd_barrier_complete(bar, b.x, nloc, nx); b.st[0] = nloc; b.st[1] = nx; }
        const unsigned old = xb_add(&bar[XB_XSUB(b.x)], 1u);
        const unsigned gen = old / nloc;
        if (old + 1u == (gen + 1u) * nloc) {
            __builtin_amdgcn_fence(__ATOMIC_RELEASE, "agent");
            asm volatile("s_waitcnt vmcnt(0)" ::: "memory");
            (void)xb_add(&bar[XB_TOP], 1u);
        }
        XB_SPIN(xb_ld(&bar[XB_TOP]) < (gen + 1u) * nx, bar);
        __builtin_amdgcn_fence(__ATOMIC_ACQUIRE, "agent");
        asm volatile("s_waitcnt vmcnt(0)" ::: "memory");
    }
    __syncthreads();
}

namespace pg8 {
constexpr int BM = 256, BK = 64, HALF = 128, HTB = HALF * BK * 2, STAGE_BYTES = 8 * HTB;
__device__ __forceinline__ int lds_byte(int r, int c) { const int st = (r >> 4) * 2 + (c >> 5), rr = r & 15, cc = c & 31, ob = rr * 64 + cc * 2; return st * 1024 + (ob ^ (((ob >> 9) & 1) << 5)); }
__device__ __forceinline__ void stage_rc(int b, int& R, int& C) { const int st = b / 1024, sb = b % 1024, swz = sb ^ (((sb >> 9) & 1) << 5); R = (st >> 1) * 16 + swz / 64; C = (st & 1) * 32 + (swz % 64) / 2; }
__device__ __forceinline__ int perm32(int rho) { const int n = rho >> 4, i = rho & 15; return 8 * (i >> 2) + 4 * n + (i & 3); }

struct GUnit { const char* A; const char* B; int nt; int orow, ocol, aux; };

__device__ __forceinline__ void tile_swz(int L, int nM, int nN, int& pm, int& pn) {
    const int nwg = nM * nN; int wgid = L;
    { const int q = nwg / 8, r = nwg % 8, xcd = wgid % 8, off = wgid / 8; wgid = (xcd < r ? xcd * (q + 1) : r * (q + 1) + (xcd - r) * q) + off; }
    const int nig = 8 * nN, gid = wgid / nig, fm = gid * 8, gsz = (nM - fm) < 8 ? (nM - fm) : 8;
    pm = fm + ((wgid % nig) % gsz); pn = (wgid % nig) / gsz;
}

template <class Epi, class Sched, bool ALIGN_EPI, bool SP2>
__device__ __forceinline__ void gemm_phase(LAS unsigned char* lds, const int lda, const int ldb, const Sched& S, const Epi& E) {
    int tid_ = threadIdx.x; asm volatile("" : "+v"(tid_));
    const int tid = tid_, wid = __builtin_amdgcn_readfirstlane(tid >> 6), lane = tid & 63, wr = wid >> 2, wc = wid & 3, fr = lane & 15, fq = lane >> 4;
    unsigned voffA[2], voffB[2];
#pragma unroll
    for (int i = 0; i < 2; ++i) { int R, C; stage_rc(tid * 16 + i * 8192, R, C); const int Rb = (R & ~31) + perm32(R & 31);
        voffA[i] = (unsigned)(R * lda + C) * 2u; voffB[i] = (unsigned)(Rb * ldb + C) * 2u; }
    const size_t kstep = (size_t)(BK * 2);
    const size_t hstepA = (size_t)HALF * lda * 2, hstepB = (size_t)HALF * ldb * 2;
    const unsigned ldsw = (unsigned)wid * 1024u;
    const int aoff = lds_byte(wr * 64 + fr, fq * 8), boff = lds_byte(wc * 32 + fr, fq * 8);
#define PG8_SA(b, h) (((b) * 2 + (h)) * HTB)
#define PG8_SB(b, h) ((4 + (b) * 2 + (h)) * HTB)
#define PG8_STAGE(bufoff, gbase, voff) do { _Pragma("unroll") for (int _i = 0; _i < 2; ++_i) \
        __builtin_amdgcn_global_load_lds((const unsigned*)((const char*)(gbase) + (voff)[_i]), (LAS unsigned*)(lds + (bufoff) + ldsw + _i * 8192), 16, 0, 0); } while (0)
#define PG8_LDA(dst, b, h) do { _Pragma("unroll") for (int m = 0; m < 4; ++m) _Pragma("unroll") for (int k = 0; k < 2; ++k) dst[m][k] = *(const LAS bf16x8*)(lds + PG8_SA(b, h) + aoff + m * 2048 + k * 1024); } while (0)
#define PG8_LDB(dst, b, h) do { _Pragma("unroll") for (int n = 0; n < 2; ++n) _Pragma("unroll") for (int k = 0; k < 2; ++k) dst[n][k] = *(const LAS bf16x8*)(lds + PG8_SB(b, h) + boff + n * 2048 + k * 1024); } while (0)
#define PG8_MMA(ai, bj, At, Bt) do { __builtin_amdgcn_s_setprio(1); _Pragma("unroll") for (int m = 0; m < 4; ++m) _Pragma("unroll") for (int n = 0; n < 2; ++n) _Pragma("unroll") for (int k = 0; k < 2; ++k) \
        acc[ai][bj][m][n] = __builtin_amdgcn_mfma_f32_16x16x32_bf16(Bt[n][k], At[m][k], acc[ai][bj][m][n], 0, 0, 0); __builtin_amdgcn_s_setprio(0); } while (0)
#define PG8_WAIT_V(n) asm volatile("s_waitcnt vmcnt(" #n ")" ::: "memory")
#define PG8_WAIT_L(n) asm volatile("s_waitcnt lgkmcnt(" #n ")" ::: "memory")
#define PG8_BAR __builtin_amdgcn_s_barrier()
#define PG8_SCHED __builtin_amdgcn_sched_barrier(0)
    GUnit cur, nxt; int ui = 0;
    if (!S.next(0, cur)) return;
    f32x4 acc[2][2][4][2];
#pragma unroll
    for (int a = 0; a < 2; ++a)
#pragma unroll
        for (int b = 0; b < 2; ++b)
#pragma unroll
            for (int m = 0; m < 4; ++m)
#pragma unroll
                for (int n = 0; n < 2; ++n) acc[a][b][m][n] = (f32x4){0.f, 0.f, 0.f, 0.f};
    bf16x8 At[4][2], B0[2][2], B1[2][2];
    const char* cA = cur.A; const char* cB = cur.B;
    if constexpr (SP2) {
        PG8_STAGE(PG8_SB(0, 0), cB, voffB); PG8_STAGE(PG8_SB(0, 1), cB + hstepB, voffB); PG8_STAGE(PG8_SA(0, 0), cA, voffA); PG8_STAGE(PG8_SA(0, 1), cA + hstepA, voffA);
        if (wr == 1) PG8_BAR;
        PG8_WAIT_V(2); PG8_BAR;
        PG8_STAGE(PG8_SB(1, 0), cB + kstep, voffB); PG8_STAGE(PG8_SA(1, 0), cA + kstep, voffA); PG8_STAGE(PG8_SB(1, 1), cB + hstepB + kstep, voffB);
        PG8_WAIT_V(6); PG8_BAR;
    } else {
        PG8_STAGE(PG8_SB(0, 0), cB, voffB); PG8_STAGE(PG8_SA(0, 0), cA, voffA); PG8_STAGE(PG8_SB(0, 1), cB + hstepB, voffB); PG8_STAGE(PG8_SA(0, 1), cA + hstepA, voffA);
        if (wr == 1) PG8_BAR;
        PG8_WAIT_V(4); PG8_BAR;
        PG8_STAGE(PG8_SB(1, 0), cB + kstep, voffB); PG8_STAGE(PG8_SA(1, 0), cA + kstep, voffA); PG8_STAGE(PG8_SB(1, 1), cB + hstepB + kstep, voffB);
        PG8_WAIT_V(6); PG8_BAR;
    }
    for (;;) {
        const bool has_next = S.next(ui + 1, nxt);
        const char* nA = has_next ? nxt.A : cA; const char* nB = has_next ? nxt.B : cB;
        const int nt = cur.nt;
        for (int t = 0; t < nt; t += 2) {
            const bool last = (t == nt - 2);
            const char* a1 = cA + (size_t)(t + 1) * kstep;
            const char* a2 = last ? nA : cA + (size_t)(t + 2) * kstep; const char* b2 = last ? nB : cB + (size_t)(t + 2) * kstep;
            const char* a3 = a2 + kstep; const char* b3 = b2 + kstep;
            if constexpr (SP2) {
            PG8_LDB(B0, 0, 0); PG8_LDB(B1, 0, 1); PG8_SCHED; PG8_LDA(At, 0, 0); PG8_STAGE(PG8_SA(1, 1), a1 + hstepA, voffA);
            PG8_WAIT_V(8); PG8_WAIT_L(0); PG8_BAR; PG8_MMA(0, 0, At, B0); PG8_MMA(0, 1, At, B1); PG8_BAR; PG8_SCHED;
            PG8_LDA(At, 0, 1); PG8_STAGE(PG8_SB(0, 0), b2, voffB); PG8_STAGE(PG8_SB(0, 1), b2 + hstepB, voffB); PG8_STAGE(PG8_SA(0, 0), a2, voffA);
            PG8_WAIT_V(8); PG8_WAIT_L(0); PG8_BAR; PG8_MMA(1, 0, At, B0); PG8_MMA(1, 1, At, B1); PG8_BAR; PG8_SCHED;
            PG8_LDB(B0, 1, 0); PG8_LDB(B1, 1, 1); PG8_SCHED; PG8_LDA(At, 1, 0); PG8_STAGE(PG8_SA(0, 1), a2 + hstepA, voffA);
            PG8_WAIT_V(8); PG8_WAIT_L(0); PG8_BAR; PG8_MMA(0, 0, At, B0); PG8_MMA(0, 1, At, B1); PG8_BAR; PG8_SCHED;
            PG8_LDA(At, 1, 1); PG8_STAGE(PG8_SB(1, 0), b3, voffB); PG8_STAGE(PG8_SB(1, 1), b3 + hstepB, voffB); PG8_STAGE(PG8_SA(1, 0), a3, voffA);
            PG8_WAIT_V(8); PG8_WAIT_L(0); PG8_BAR; PG8_MMA(1, 0, At, B0); PG8_MMA(1, 1, At, B1); PG8_BAR; PG8_SCHED;
            } else {
            PG8_LDB(B0, 0, 0); PG8_SCHED; PG8_LDA(At, 0, 0); PG8_STAGE(PG8_SA(1, 1), a1 + hstepA, voffA);
            PG8_WAIT_L(8); PG8_BAR; PG8_WAIT_L(0); PG8_MMA(0, 0, At, B0); PG8_BAR; PG8_SCHED;
            PG8_LDB(B1, 0, 1); PG8_STAGE(PG8_SB(0, 0), b2, voffB);
            PG8_BAR; PG8_WAIT_L(0); PG8_MMA(0, 1, At, B1); PG8_BAR;
            PG8_LDA(At, 0, 1); PG8_STAGE(PG8_SA(0, 0), a2, voffA);
            PG8_BAR; PG8_WAIT_L(0); PG8_MMA(1, 0, At, B0); PG8_BAR; PG8_SCHED;
            PG8_STAGE(PG8_SB(0, 1), b2 + hstepB, voffB);
            PG8_WAIT_V(6); PG8_BAR; PG8_MMA(1, 1, At, B1); PG8_BAR;
            PG8_LDB(B0, 1, 0); PG8_SCHED; PG8_LDA(At, 1, 0); PG8_STAGE(PG8_SA(0, 1), a2 + hstepA, voffA);
            PG8_WAIT_L(8); PG8_BAR; PG8_WAIT_L(0); PG8_MMA(0, 0, At, B0); PG8_BAR; PG8_SCHED;
            PG8_LDB(B1, 1, 1); PG8_STAGE(PG8_SB(1, 0), b3, voffB);
            PG8_BAR; PG8_WAIT_L(0); PG8_MMA(0, 1, At, B1); PG8_BAR;
            PG8_LDA(At, 1, 1); PG8_STAGE(PG8_SA(1, 0), a3, voffA);
            PG8_BAR; PG8_WAIT_L(0); PG8_MMA(1, 0, At, B0); PG8_BAR; PG8_SCHED;
            PG8_STAGE(PG8_SB(1, 1), b3 + hstepB, voffB);
            PG8_WAIT_V(6); PG8_BAR; PG8_MMA(1, 1, At, B1); PG8_BAR;
            }
        }
        if constexpr (ALIGN_EPI) { if (wr == 0) PG8_BAR; }
        E(acc, cur, wr, wc, fr, fq);
        if (!has_next) break;
#pragma unroll
        for (int a = 0; a < 2; ++a)
#pragma unroll
            for (int b = 0; b < 2; ++b)
#pragma unroll
                for (int m = 0; m < 4; ++m)
#pragma unroll
                    for (int n = 0; n < 2; ++n) acc[a][b][m][n] = (f32x4){0.f, 0.f, 0.f, 0.f};
        cur = nxt; cA = nA; cB = nB; ++ui;
        if constexpr (ALIGN_EPI) { if (wr == 1) PG8_BAR; }
    }
    PG8_WAIT_V(0);
    if constexpr (!ALIGN_EPI) { if (wr == 0) PG8_BAR; }
    PG8_BAR;
#undef PG8_SA
#undef PG8_SB
#undef PG8_STAGE
#undef PG8_LDA
#undef PG8_LDB
#undef PG8_MMA
#undef PG8_WAIT_V
#undef PG8_WAIT_L
#undef PG8_BAR
#undef PG8_SCHED
}

__device__ __forceinline__ int panel_row(int pm, int latonly) { return latonly ? ((pm >> 3) * TPB + CTXL + (pm & 7) * 256) : pm * 256; }
struct SchedRows {
    const char* A; const char* B; int lda, ldb, nM, nN, nt, latonly, G, c; int auxoff = 0;
    __device__ __forceinline__ bool next(int i, GUnit& u) const {
        const int L = i * G + c; if (L >= nM * nN) return false;
        int pm, pn; tile_swz(L, nM, nN, pm, pn); const int row = panel_row(pm, latonly);
        u.A = A + (size_t)row * lda * 2; u.B = B + (size_t)pn * 256 * ldb * 2; u.nt = nt; u.orow = row; u.ocol = pn * 256; u.aux = pn + auxoff; return true;
    }
};
struct SchedRowsSK {
    const char* A; const char* B; int lda, ldb, ntfull, G, c;
    __device__ __forceinline__ bool next(int i, GUnit& u) const {
        if (i == 0) { int pm, pn; tile_swz(c, 32, 8, pm, pn); const int row = panel_row(pm, 1);
            u.A = A + (size_t)row * lda * 2; u.B = B + (size_t)pn * 256 * ldb * 2; u.nt = ntfull; u.orow = row; u.ocol = pn * 256; u.aux = 0; return true; }
        if (i == 1) { const int id = c >> 3, ks = c & 7, b = id >> 3, pn = id & 7, kof = ks * (ntfull / 8) * 64;
            u.A = A + ((size_t)(b * TPB) * lda + kof) * 2; u.B = B + ((size_t)pn * 256 * ldb + kof) * 2; u.nt = ntfull / 8; u.orow = b * CTXL; u.ocol = pn * 256; u.aux = 1 + ks; return true; }
        return false;
    }
};
struct SchedSeqDft {
    const char* CS; const char* HT; const char* CS256; const char* HTC; int with_ctx, G, c;
    __device__ __forceinline__ bool next(int i, GUnit& u) const {
        const int L = i * G + c;
        if (L < 256) { int pm, pn; tile_swz(L, 32, 8, pm, pn); const int b = pm >> 3, p = pm & 7;
            u.A = CS + (size_t)p * 256 * 2048 * 2; u.B = HT + ((size_t)b * 2048 + pn * 256) * 2048 * 2; u.nt = 32; u.orow = b * 1024 + (p & 3) * 256; u.ocol = pn * 512 + (p >> 2) * 256; u.aux = 0; return true; }
        if (with_ctx && L < 320) { const int e = L - 256, b = e >> 4, p = (e >> 3) & 1, pn = e & 7;
            u.A = CS256 + (size_t)p * 256 * 2048 * 2; u.B = HTC + ((size_t)b * 2048 + pn * 256) * 2048 * 2; u.nt = 4; u.orow = b * 256; u.ocol = pn * 512 + p * 256; u.aux = 1; return true; }
        return false;
    }
};
struct SchedChanDft {
    const char* PQ; const char* PQC; const char* CC2; const char* CC3; int with_ctx, G, c;
    __device__ __forceinline__ bool next(int i, GUnit& u) const {
        const int L = i * G + c;
        if (L < 256) { int pm, pn; tile_swz(L, 16, 16, pm, pn); const int b = pm >> 2, lt = pm & 3, g = pn >> 1, sgn = pn & 1;
            u.A = PQ + (((size_t)b * 1024 + lt * 256) * 4096 + g * 512) * 2; u.B = CC2 + (size_t)sgn * 256 * 512 * 2; u.nt = 8; u.ocol = g * 256;
            u.orow = b * TPB + CTXL + (sgn ? SEQ - lt * 256 : lt * 256); u.aux = (lt == 0 ? 1 : 0) | (sgn ? 2 : 0); return true; }
        if (L < 320) { const int e = L - 256, b = e >> 4, g = (e >> 1) & 7, half = e & 1;
            u.A = PQ + (((size_t)b * 1024) * 4096 + g * 512) * 2; u.B = CC3 + (size_t)half * 256 * 512 * 2; u.nt = 8; u.ocol = g * 256; u.orow = b * TPB + CTXL + half * 1024; u.aux = 4; return true; }
        if (with_ctx && L < 352) { const int e = L - 320, b = e >> 3, g = e & 7;
            u.A = PQC + ((size_t)b * 256 * 4096 + g * 512) * 2; u.B = CC2; u.nt = 8; u.orow = b * TPB; u.ocol = g * 256; u.aux = 0; return true; }
        return false;
    }
};

template <int ACT  > struct EpiBf16 {
    unsigned char* ws; size_t off0, off1; int ldc;
    __device__ __forceinline__ void operator()(f32x4 (&acc)[2][2][4][2], const GUnit& u, int wr, int wc, int fr, int fq) const {
        bf16_t* base = (bf16_t*)(ws + (u.aux ? off1 : off0));
        const int row0 = u.orow + wr * 64 + fr, col0 = u.ocol + wc * 32 + 8 * fq;
#pragma unroll
        for (int ai = 0; ai < 2; ++ai)
#pragma unroll
            for (int m = 0; m < 4; ++m) { bf16_t* rowp = base + (size_t)(row0 + ai * HALF + m * 16) * ldc + col0;
#pragma unroll
                for (int bj = 0; bj < 2; ++bj) { f32x4 v0 = acc[ai][bj][m][0], v1 = acc[ai][bj][m][1];
                    if (ACT == 1) {
#pragma unroll
                        for (int j = 0; j < 4; ++j) { const float a = fmaxf(v0[j], 0.f), b = fmaxf(v1[j], 0.f); v0[j] = a * a; v1[j] = b * b; } }
                    u32x4 w; w.x = cvt_pk_bf16(v0[0], v0[1]); w.y = cvt_pk_bf16(v0[2], v0[3]); w.z = cvt_pk_bf16(v1[0], v1[1]); w.w = cvt_pk_bf16(v1[2], v1[3]);
                    *(u32x4*)(rowp + bj * HALF) = w; } }
    }
};
struct EpiChan {
    bf16_t* O;
    __device__ __forceinline__ void operator()(f32x4 (&acc)[2][2][4][2], const GUnit& u, int wr, int wc, int fr, int fq) const {
        const int col0 = u.ocol + wc * 32 + 8 * fq;
#pragma unroll
        for (int ai = 0; ai < 2; ++ai)
#pragma unroll
            for (int m = 0; m < 4; ++m) { const int r = ai * HALF + wr * 64 + m * 16 + fr;
                const bool on = (u.aux & 4) ? (r == 0) : !((u.aux & 1) && r == 0);
                const int drow = (u.aux & 4) ? u.orow : ((u.aux & 2) ? u.orow - r : u.orow + r);
                bf16_t* rowp = O + (size_t)drow * 2048 + col0;
                if (on) {
#pragma unroll
                    for (int bj = 0; bj < 2; ++bj) { const f32x4 v0 = acc[ai][bj][m][0], v1 = acc[ai][bj][m][1];
                        u32x4 w; w.x = cvt_pk_bf16(v0[0], v0[1]); w.y = cvt_pk_bf16(v0[2], v0[3]); w.z = cvt_pk_bf16(v1[0], v1[1]); w.w = cvt_pk_bf16(v1[2], v1[3]);
                        *(u32x4*)(rowp + bj * HALF) = w; } } }
    }
};
struct EpiF32 {
    unsigned char* ws; size_t off0, off1, slab; int ldc;
    __device__ __forceinline__ void operator()(f32x4 (&acc)[2][2][4][2], const GUnit& u, int wr, int wc, int fr, int fq) const {
        const int row0 = u.orow + wr * 64 + fr, col0 = u.ocol + wc * 32 + 8 * fq;
        if (u.aux && slab) {
            bf16_t* C = (bf16_t*)(ws + off1 + (size_t)(u.aux - 1) * slab);
#pragma unroll
            for (int ai = 0; ai < 2; ++ai)
#pragma unroll
                for (int m = 0; m < 4; ++m) { bf16_t* rowp = C + (size_t)(row0 + ai * HALF + m * 16) * ldc + col0;
#pragma unroll
                    for (int bj = 0; bj < 2; ++bj) { const f32x4 v0 = acc[ai][bj][m][0], v1 = acc[ai][bj][m][1];
                        u32x4 w; w.x = cvt_pk_bf16(v0[0], v0[1]); w.y = cvt_pk_bf16(v0[2], v0[3]); w.z = cvt_pk_bf16(v1[0], v1[1]); w.w = cvt_pk_bf16(v1[2], v1[3]);
                        *(u32x4*)(rowp + bj * HALF) = w; } }
        } else {
            bf16_t* C = (bf16_t*)(ws + off0);
#pragma unroll
            for (int ai = 0; ai < 2; ++ai)
#pragma unroll
                for (int m = 0; m < 4; ++m) { bf16_t* rowp = C + (size_t)(row0 + ai * HALF + m * 16) * ldc + col0;
#pragma unroll
                    for (int bj = 0; bj < 2; ++bj) { const f32x4 v0 = acc[ai][bj][m][0], v1 = acc[ai][bj][m][1];
                        u32x4 w; w.x = cvt_pk_bf16(v0[0], v0[1]); w.y = cvt_pk_bf16(v0[2], v0[3]); w.z = cvt_pk_bf16(v1[0], v1[1]); w.w = cvt_pk_bf16(v1[2], v1[3]);
                        *(u32x4*)(rowp + bj * HALF) = w; } }
        }
    }
};
__device__ __forceinline__ float fast_sigmoid(float z) { return __builtin_amdgcn_rcpf(1.f + __builtin_amdgcn_exp2f(-1.4426950408889634f * z)); }
struct EpiHgrn {
    unsigned char* ws; const float* lb;
    __device__ __forceinline__ void operator()(f32x4 (&acc)[2][2][4][2], const GUnit& u, int wr, int wc, int fr, int fq) const {
        const int ty = u.aux >> 3, ocol = (u.aux & 7) * 256;
        const int row0 = u.orow + wr * 64 + fr, col0 = ocol + wc * 32 + 8 * fq;
        if (ty == 1 || ty == 2) {
            const int dir = ty - 1; _Float16* lf = (_Float16*)(ws + SC_HLF) + (size_t)dir * ACT_ELEMS; bf16_t* kk = (bf16_t*)(ws + SC_HK) + (size_t)dir * ACT_ELEMS;
#pragma unroll
            for (int bj = 0; bj < 2; ++bj) {
                const f32x4 l0 = *(const f32x4*)(lb + dir * 2048 + col0 + bj * HALF), l1 = *(const f32x4*)(lb + dir * 2048 + col0 + bj * HALF + 4);
#pragma unroll
                for (int ai = 0; ai < 2; ++ai)
#pragma unroll
                    for (int m = 0; m < 4; ++m) { const size_t off = (size_t)(row0 + ai * HALF + m * 16) * 2048 + col0 + bj * HALF;
                        const f32x4 z0 = acc[ai][bj][m][0], z1 = acc[ai][bj][m][1]; f32x4 f0, f1, k0, k1;
#pragma unroll
                        for (int j = 0; j < 4; ++j) {
                            const float s0 = fast_sigmoid(z0[j]), s1 = fast_sigmoid(z1[j]);
                            const float la = l0[j], lc = l1[j];
                            f0[j] = 0.6931471805599453f * __builtin_amdgcn_logf(la + (1.f - la) * s0); f1[j] = 0.6931471805599453f * __builtin_amdgcn_logf(lc + (1.f - lc) * s1);
                            k0[j] = (1.f - la) * (1.f - s0); k1[j] = (1.f - lc) * (1.f - s1); }
                        { typedef _Float16 h8 __attribute__((ext_vector_type(8))); h8 hv; hv[0] = (_Float16)f0[0]; hv[1] = (_Float16)f0[1]; hv[2] = (_Float16)f0[2]; hv[3] = (_Float16)f0[3]; hv[4] = (_Float16)f1[0]; hv[5] = (_Float16)f1[1]; hv[6] = (_Float16)f1[2]; hv[7] = (_Float16)f1[3];
                          *(h8*)(lf + off) = hv; }
                        u32x4 w; w.x = cvt_pk_bf16(k0[0], k0[1]); w.y = cvt_pk_bf16(k0[2], k0[3]); w.z = cvt_pk_bf16(k1[0], k1[1]); w.w = cvt_pk_bf16(k1[2], k1[3]);
                        *(u32x4*)(kk + off) = w;
                        __builtin_amdgcn_sched_barrier(0); }
            }
        } else {
            bf16_t* O = (bf16_t*)(ws + (ty == 0 ? SC_HQ : (ty == 3 ? SC_HV : SC_HG)));
#pragma unroll
            for (int ai = 0; ai < 2; ++ai)
#pragma unroll
                for (int m = 0; m < 4; ++m) { bf16_t* rowp = O + (size_t)(row0 + ai * HALF + m * 16) * 2048 + col0;
#pragma unroll
                    for (int bj = 0; bj < 2; ++bj) { f32x4 v0 = acc[ai][bj][m][0], v1 = acc[ai][bj][m][1];
                        if (ty == 4) {
#pragma unroll
                            for (int j = 0; j < 4; ++j) { v0[j] = v0[j] * fast_sigmoid(v0[j]); v1[j] = v1[j] * fast_sigmoid(v1[j]); } }
                        u32x4 w; w.x = cvt_pk_bf16(v0[0], v0[1]); w.y = cvt_pk_bf16(v0[2], v0[3]); w.z = cvt_pk_bf16(v1[0], v1[1]); w.w = cvt_pk_bf16(v1[2], v1[3]);
                        *(u32x4*)(rowp + bj * HALF) = w; }
                    __builtin_amdgcn_sched_barrier(0); }
        }
    }
};
struct EpiQkv {
    unsigned char* ws; const float* rc; const float* rs;
    __device__ __forceinline__ void operator()(f32x4 (&acc)[2][2][4][2], const GUnit& u, int wr, int wc, int fr, int fq) const {
        const int ty = u.aux >> 3, ocol = (u.aux & 7) * 256;
        bf16_t* O = (bf16_t*)(ws + (ty == 0 ? SC_DQ : (ty == 1 ? SC_DK : SC_DV)));
        const int row0 = u.orow + wr * 64 + fr, col0 = ocol + wc * 32 + 8 * fq;
        const int prow = u.orow % TPB;
        const bool rope = ty < 2 && prow >= CTXL;
        const unsigned toff = rope ? (unsigned)((prow - CTXL + wr * 64 + fr) * 64 + 16 * wc + 4 * fq) : 0u;
        const unsigned tstep = rope ? 64u : 0u;
#pragma unroll
        for (int ai = 0; ai < 2; ++ai)
#pragma unroll
            for (int m = 0; m < 4; ++m) { const unsigned t = toff + (unsigned)(ai * HALF + m * 16) * tstep;
                f32x4 cs = *(const f32x4*)(rc + t), sn = *(const f32x4*)(rs + t);
                if (!rope) { cs = (f32x4){1.f, 1.f, 1.f, 1.f}; sn = (f32x4){0.f, 0.f, 0.f, 0.f}; }
                bf16_t* rowp = O + (size_t)(row0 + ai * HALF + m * 16) * 2048 + col0;
#pragma unroll
                for (int bj = 0; bj < 2; ++bj) { const f32x4 v0 = acc[ai][bj][m][0], v1 = acc[ai][bj][m][1]; f32x4 o0, o1;
                    o0[0] = v0[0] * cs[0] - v0[1] * sn[0]; o0[1] = v0[0] * sn[0] + v0[1] * cs[0];
                    o0[2] = v0[2] * cs[1] - v0[3] * sn[1]; o0[3] = v0[2] * sn[1] + v0[3] * cs[1];
                    o1[0] = v1[0] * cs[2] - v1[1] * sn[2]; o1[1] = v1[0] * sn[2] + v1[1] * cs[2];
                    o1[2] = v1[2] * cs[3] - v1[3] * sn[3]; o1[3] = v1[2] * sn[3] + v1[3] * cs[3];
                    u32x4 w; w.x = cvt_pk_bf16(o0[0], o0[1]); w.y = cvt_pk_bf16(o0[2], o0[3]); w.z = cvt_pk_bf16(o1[0], o1[1]); w.w = cvt_pk_bf16(o1[2], o1[3]);
                    *(u32x4*)(rowp + bj * HALF) = w; }
                asm volatile("" ::: "memory"); __builtin_amdgcn_sched_barrier(0); }
    }
};
}

namespace attn {
constexpr int D = 128, NW = 8, QBLK = 32, KVBLK = 64, LD = 2048;
constexpr float SCALE = 0.088388347648318440f;
constexpr float THR = 8.f;
constexpr size_t SHM_V = KVBLK * D * 2, SHM_K = KVBLK * D * 2, SHM_ATTN = 2 * SHM_V + 2 * SHM_K + NW * 64 * 4;
#define KSWZ(row, colB) ((row) * 256 + ((colB) ^ (((row) & 7) << 4)))
#define SBAR() __builtin_amdgcn_sched_barrier(0)
__device__ __forceinline__ int crow(int r, int hi) { return (r & 3) + 8 * (r >> 2) + 4 * hi; }
__device__ __forceinline__ unsigned cvtpk(float lo, float hi) { return cvt_pk_bf16(lo, hi); }
__device__ __forceinline__ void partialSM(f32x16& p0, f32x16& p1, float& m_reg, float& mn, float& alpha) {
  constexpr float C = SCALE * 1.4426950408889634f;
  float pmax = p0[0];
#pragma unroll
  for (int r = 1; r < 16; ++r) pmax = fmaxf(pmax, p0[r]);
#pragma unroll
  for (int r = 0; r < 16; ++r) pmax = fmaxf(pmax, p1[r]);
  { auto rr = __builtin_amdgcn_permlane32_swap(__float_as_uint(pmax), __float_as_uint(pmax), false, false);
    pmax = fmaxf(__uint_as_float(rr[0]), __uint_as_float(rr[1])); }
  if (__builtin_expect(__all(pmax - m_reg <= THR / SCALE), 1)) { mn = m_reg; alpha = 1.f; }
  else { mn = fmaxf(m_reg, pmax); alpha = __builtin_amdgcn_exp2f((m_reg - mn) * C); m_reg = mn; }
  float mnC = -mn * C;
#pragma unroll
  for (int r = 0; r < 16; ++r) p0[r] = fmaf(p0[r], C, mnC);
#pragma unroll
  for (int r = 0; r < 16; ++r) p1[r] = fmaf(p1[r], C, mnC);
#pragma unroll
  for (int r = 0; r < 16; ++r) p0[r] = __builtin_amdgcn_exp2f(p0[r]);
}
__device__ __forceinline__ void finishSM(f32x16& p0, f32x16& p1, float alpha, float& l_reg, bf16x8& pa0, bf16x8& pa1, bf16x8& pa2, bf16x8& pa3) {
#pragma unroll
  for (int r = 0; r < 16; ++r) p1[r] = __builtin_amdgcn_exp2f(p1[r]);
  float ps = 0;
#pragma unroll
  for (int r = 0; r < 16; ++r) ps += p0[r];
#pragma unroll
  for (int r = 0; r < 16; ++r) ps += p1[r];
  { auto rr = __builtin_amdgcn_permlane32_swap(__float_as_uint(ps), __float_as_uint(ps), false, false);
    ps = __uint_as_float(rr[0]) + __uint_as_float(rr[1]); }
  l_reg = l_reg * alpha + ps;
#define PK4(P, BASE, OUT) do { unsigned a0 = cvtpk(P[BASE + 0], P[BASE + 1]), a1 = cvtpk(P[BASE + 2], P[BASE + 3]);   \
    unsigned b0 = cvtpk(P[BASE + 4], P[BASE + 5]), b1 = cvtpk(P[BASE + 6], P[BASE + 7]);                              \
    auto r0 = __builtin_amdgcn_permlane32_swap(a0, b0, false, false); auto r1 = __builtin_amdgcn_permlane32_swap(a1, b1, false, false); \
    u32x4 w = {r0[0], r1[0], r0[1], r1[1]}; OUT = *reinterpret_cast<bf16x8*>(&w); } while (0)
  PK4(p0, 0, pa0); PK4(p0, 8, pa1); PK4(p1, 0, pa2); PK4(p1, 8, pa3);
#undef PK4
}
__device__ __forceinline__ void qkt(f32x16& p0, f32x16& p1, const bf16_t* Ks, const bf16x8* qr, int r32, int hi) {
  p0 = f32x16{}; p1 = f32x16{};
#pragma unroll
  for (int d0 = 0; d0 < 8; ++d0) { int cb = (d0 * 16 + hi * 8) * 2;
    bf16x8 b0 = *reinterpret_cast<const bf16x8*>((const char*)Ks + KSWZ(r32, cb));
    bf16x8 b1 = *reinterpret_cast<const bf16x8*>((const char*)Ks + KSWZ(32 + r32, cb));
    p0 = __builtin_amdgcn_mfma_f32_32x32x16_bf16(b0, qr[d0], p0, 0, 0, 0);
    p1 = __builtin_amdgcn_mfma_f32_32x32x16_bf16(b1, qr[d0], p1, 0, 0, 0); }
}
__device__ __forceinline__ int v_st(int k, int c) { const int kk = (k & ~0xC) | ((k & 4) << 1) | ((k & 8) >> 1); return ((kk >> 3) * 4 + (c >> 5)) * 512 + ((kk & 7) * 32 + (c & 31)) * 2; }
__device__ __forceinline__ int v_rd_base(int lane) { return ((lane & 3) << 3) | (((lane >> 2) & 3) << 6) | (((lane >> 4) & 1) << 5) | (((lane >> 5) & 1) << 8); }
constexpr int v_rd_off(int d0, int ks, int half) { return d0 * 512 + ks * 4096 + half * 2048; }
template <int OFF> __device__ __forceinline__ s16x4 tr_read(int vb) {
  s16x4 r; asm volatile("ds_read_b64_tr_b16 %0, %1 offset:%2" : "=&v"(r) : "v"(vb), "i"(OFF) : "memory"); return r;
}
template <int D0> __device__ __forceinline__ void pv_one(f32x16& od, int vb, bf16x8 pa0, bf16x8 pa1, bf16x8 pa2, bf16x8 pa3) {
  const s16x4 l0 = tr_read<v_rd_off(D0, 0, 0)>(vb), h0 = tr_read<v_rd_off(D0, 0, 1)>(vb), l1 = tr_read<v_rd_off(D0, 1, 0)>(vb), h1 = tr_read<v_rd_off(D0, 1, 1)>(vb);
  const s16x4 l2 = tr_read<v_rd_off(D0, 2, 0)>(vb), h2 = tr_read<v_rd_off(D0, 2, 1)>(vb), l3 = tr_read<v_rd_off(D0, 3, 0)>(vb), h3 = tr_read<v_rd_off(D0, 3, 1)>(vb);
  asm volatile("s_waitcnt lgkmcnt(0)" ::: "memory"); SBAR();
#define PK(L, H) (bf16x8){L[0], L[1], L[2], L[3], H[0], H[1], H[2], H[3]}
  od = __builtin_amdgcn_mfma_f32_32x32x16_bf16(pa0, PK(l0, h0), od, 0, 0, 0);
  od = __builtin_amdgcn_mfma_f32_32x32x16_bf16(pa1, PK(l1, h1), od, 0, 0, 0);
  od = __builtin_amdgcn_mfma_f32_32x32x16_bf16(pa2, PK(l2, h2), od, 0, 0, 0);
  od = __builtin_amdgcn_mfma_f32_32x32x16_bf16(pa3, PK(l3, h3), od, 0, 0, 0);
#undef PK
}
__device__ __forceinline__ void pv_d0(f32x16* o, int vb, bf16x8 pa0, bf16x8 pa1, bf16x8 pa2, bf16x8 pa3) {
  pv_one<0>(o[0], vb, pa0, pa1, pa2, pa3); pv_one<1>(o[1], vb, pa0, pa1, pa2, pa3); pv_one<2>(o[2], vb, pa0, pa1, pa2, pa3); pv_one<3>(o[3], vb, pa0, pa1, pa2, pa3);
}
__device__ __forceinline__ void attn_dense_body(const bf16_t* __restrict__ Qb, const bf16_t* __restrict__ Kh, const bf16_t* __restrict__ Vh,
                                                bf16_t* __restrict__ Ob, int seq, char* lds) {
  int tid_ = threadIdx.x; asm volatile("" : "+v"(tid_));
  const int tid = tid_, wid = tid >> 6, lane = tid & 63, r32 = lane & 31, hi = lane >> 5;
  bf16_t* V_lds = (bf16_t*)lds; bf16_t* K_lds = (bf16_t*)(lds + 2 * SHM_V);
  float* ws = (float*)(lds + 2 * SHM_V + 2 * SHM_K) + wid * 64; float* li_l = ws; float* al_l = ws + 32;
  float m_reg = -1e30f, l_reg = 0; f32x16 o[4] = {}; bf16x8 qr[8];
  const bf16_t* Qw = Qb + (long)(wid * QBLK + r32) * LD + hi * 8;
#pragma unroll
  for (int d0 = 0; d0 < 8; ++d0) qr[d0] = *reinterpret_cast<const bf16x8*>(Qw + d0 * 16);
  const int sr = tid >> 4, sc = (tid & 15) * 8, vst0 = v_st(sr, sc), vst1 = v_st(32 + sr, sc);
  const int vb0 = (int)(uintptr_t)V_lds + v_rd_base(lane);
  struct { bf16x8 vs0, vs1, ks0, ks1; } sr_[2];
#define SLOAD(i, k0) do { sr_[i].vs0 = *reinterpret_cast<const bf16x8*>(&Vh[(long)((k0) + sr) * LD + sc]); sr_[i].vs1 = *reinterpret_cast<const bf16x8*>(&Vh[(long)((k0) + 32 + sr) * LD + sc]); \
    sr_[i].ks0 = *reinterpret_cast<const bf16x8*>(&Kh[(long)((k0) + sr) * LD + sc]); sr_[i].ks1 = *reinterpret_cast<const bf16x8*>(&Kh[(long)((k0) + 32 + sr) * LD + sc]); } while (0)
#define SWRITE(b, i) do { *(bf16x8*)((char*)V_lds + (b) * SHM_V + vst0) = sr_[i].vs0;          \
    *(bf16x8*)((char*)V_lds + (b) * SHM_V + vst1) = sr_[i].vs1; int kc = sc * 2;               \
    *(bf16x8*)((char*)K_lds + (b) * SHM_K + KSWZ(sr, kc)) = sr_[i].ks0;                       \
    *(bf16x8*)((char*)K_lds + (b) * SHM_K + KSWZ(32 + sr, kc)) = sr_[i].ks1; } while (0)
#define SWAIT() asm volatile("s_waitcnt vmcnt(4)" ::: "memory")
#define RESC(a) do { if (__any((a) < 1.f)) { if (hi == 0) al_l[r32] = (a); asm volatile("s_waitcnt lgkmcnt(0)" ::: "memory"); \
    _Pragma("unroll") for (int d = 0; d < 4; ++d) _Pragma("unroll") for (int r = 0; r < 16; ++r) o[d][r] *= al_l[crow(r, hi)]; } } while (0)
  f32x16 pA0, pA1, pB0, pB1; float mnA, mnB, alA, alB; bf16x8 pa0, pa1, pa2, pa3; const int NT = seq / KVBLK;
  constexpr int SE = 0, SO = 1;
  SLOAD(SE, 0); asm volatile("s_waitcnt vmcnt(0)" ::: "memory"); SWRITE(0, SE); __syncthreads();
  qkt(pA0, pA1, K_lds, qr, r32, hi); partialSM(pA0, pA1, m_reg, mnA, alA);
  SLOAD(SO, KVBLK); if (2 < NT) SLOAD(SE, 2 * KVBLK);
  SWAIT(); SWRITE(1, SO); __syncthreads();
  for (int j = 1; j + 1 < NT; j += 2) {
    SBAR(); qkt(pB0, pB1, (bf16_t*)((char*)K_lds + SHM_K), qr, r32, hi);
    finishSM(pA0, pA1, alA, l_reg, pa0, pa1, pa2, pa3); SBAR();
    SLOAD(SO, (j + 2) * KVBLK); SBAR();
    pv_d0(o, vb0, pa0, pa1, pa2, pa3); partialSM(pB0, pB1, m_reg, mnB, alB);
    __syncthreads(); SWAIT(); SWRITE(0, SE);
    RESC(alB); __syncthreads();
    SBAR(); qkt(pA0, pA1, K_lds, qr, r32, hi);
    finishSM(pB0, pB1, alB, l_reg, pa0, pa1, pa2, pa3); SBAR();
    if (j + 3 < NT) SLOAD(SE, (j + 3) * KVBLK); SBAR();
    pv_d0(o, vb0 + (int)SHM_V, pa0, pa1, pa2, pa3); partialSM(pA0, pA1, m_reg, mnA, alA);
    __syncthreads(); SWAIT(); SWRITE(1, SO);
    RESC(alA); __syncthreads();
  }
  SBAR(); qkt(pB0, pB1, (bf16_t*)((char*)K_lds + SHM_K), qr, r32, hi);
  finishSM(pA0, pA1, alA, l_reg, pa0, pa1, pa2, pa3); SBAR();
  pv_d0(o, vb0, pa0, pa1, pa2, pa3); partialSM(pB0, pB1, m_reg, mnB, alB);
  __syncthreads(); RESC(alB);
  finishSM(pB0, pB1, alB, l_reg, pa0, pa1, pa2, pa3); SBAR();
  pv_d0(o, vb0 + (int)SHM_V, pa0, pa1, pa2, pa3);
  if (hi == 0) li_l[r32] = l_reg; asm volatile("s_waitcnt lgkmcnt(0)" ::: "memory");
  float rli[16];
#pragma unroll
  for (int r = 0; r < 16; ++r) rli[r] = __builtin_amdgcn_rcpf(li_l[crow(r, hi)]);
  bf16_t* Ow = Ob + (long)(wid * QBLK) * LD;
#pragma unroll
  for (int r = 0; r < 16; ++r) { int orow = crow(r, hi);
#pragma unroll
    for (int d0 = 0; d0 < 4; ++d0) Ow[(long)orow * LD + d0 * 32 + r32] = (bf16_t)f2bf(o[d0][r] * rli[r]); }
  __syncthreads();
#undef SLOAD
#undef SWRITE
#undef SWAIT
#undef RESC
}

__device__ __forceinline__ void attn_pair_body(const bf16_t* __restrict__ Qb, const bf16_t* __restrict__ Kh, const bf16_t* __restrict__ Vh, bf16_t* __restrict__ Ob, int seq, char* lds) {
  int tid_ = threadIdx.x; asm volatile("" : "+v"(tid_));
  const int tid = tid_, wid = __builtin_amdgcn_readfirstlane(tid >> 6), lane = tid & 63, r32 = lane & 31, hi = lane >> 5, ph = wid >> 2, pw = wid & 3;
  char* V_lds = lds; char* K_lds = lds + 65536;
  float* wsf = (float*)(lds + 98304) + wid * 128; float* li_l = wsf; float* al_l = wsf + 32; float* mx_l = wsf + 64;
  const float* pwsf = (const float*)(lds + 98304) + (wid ^ 4) * 128;
  u32x4* pex_own = (u32x4*)(lds + 102400) + wid * 128 + lane; const u32x4* pex_par = (const u32x4*)(lds + 102400) + (wid ^ 4) * 128 + lane;
  float m_reg = -1e30f, l_reg = 0; f32x16 o[4] = {}; bf16x8 qr[8];
  const bf16_t* Qw = Qb + (long)(pw * QBLK + r32) * LD + hi * 8;
#pragma unroll
  for (int d0 = 0; d0 < 8; ++d0) qr[d0] = *reinterpret_cast<const bf16x8*>(Qw + d0 * 16);
  const int sr = tid >> 4, sc = (tid & 15) * 8, vst0 = v_st(sr, sc), vst1 = v_st(32 + sr, sc);
  const int vb0 = (int)(uintptr_t)V_lds + ph * (int)SHM_V + v_rd_base(lane);
  const int krow = ph * 32 + r32;
  const int NT = seq / KVBLK;
  struct { bf16x8 k0, k1; } ks_[2]; struct { bf16x8 v00, v01, v10, v11; } vs_[2];
#define PLOADK(i, t) do { const long k0_ = (long)((t) < NT ? (t) : NT - 1) * KVBLK; \
    ks_[i].k0 = *reinterpret_cast<const bf16x8*>(&Kh[(k0_ + sr) * LD + sc]); ks_[i].k1 = *reinterpret_cast<const bf16x8*>(&Kh[(k0_ + 32 + sr) * LD + sc]); } while (0)
#define PLOADV(i, t) do { const long k0_ = (long)((t) < NT ? (t) : NT - 1) * KVBLK; \
    vs_[i].v00 = *reinterpret_cast<const bf16x8*>(&Vh[(k0_ + sr) * LD + sc]); vs_[i].v01 = *reinterpret_cast<const bf16x8*>(&Vh[(k0_ + 32 + sr) * LD + sc]); \
    vs_[i].v10 = *reinterpret_cast<const bf16x8*>(&Vh[(k0_ + sr) * LD + 128 + sc]); vs_[i].v11 = *reinterpret_cast<const bf16x8*>(&Vh[(k0_ + 32 + sr) * LD + 128 + sc]); } while (0)
#define PWRITEK(b, i) do { const int kc = sc * 2; *(bf16x8*)(K_lds + (b) * SHM_K + KSWZ(sr, kc)) = ks_[i].k0; *(bf16x8*)(K_lds + (b) * SHM_K + KSWZ(32 + sr, kc)) = ks_[i].k1; } while (0)
#define PWRITEV(b, i) do { *(bf16x8*)(V_lds + (b) * 2 * SHM_V + vst0) = vs_[i].v00; *(bf16x8*)(V_lds + (b) * 2 * SHM_V + vst1) = vs_[i].v01; \
    *(bf16x8*)(V_lds + (b) * 2 * SHM_V + SHM_V + vst0) = vs_[i].v10; *(bf16x8*)(V_lds + (b) * 2 * SHM_V + SHM_V + vst1) = vs_[i].v11; } while (0)
#define PK4(P, BASE, OUT) do { unsigned a0 = cvtpk(P[BASE + 0], P[BASE + 1]), a1 = cvtpk(P[BASE + 2], P[BASE + 3]);   \
    unsigned b0 = cvtpk(P[BASE + 4], P[BASE + 5]), b1 = cvtpk(P[BASE + 6], P[BASE + 7]);                              \
    auto r0 = __builtin_amdgcn_permlane32_swap(a0, b0, false, false); auto r1 = __builtin_amdgcn_permlane32_swap(a1, b1, false, false); \
    OUT = (u32x4){r0[0], r1[0], r0[1], r1[1]}; } while (0)
#define PQKT(P, b) do { bf16x8 kf[4]; P = f32x16{}; \
    _Pragma("unroll") for (int d0 = 0; d0 < 4; ++d0) kf[d0] = *reinterpret_cast<const bf16x8*>(K_lds + (b) * SHM_K + KSWZ(krow, (d0 * 16 + hi * 8) * 2)); \
    asm volatile("s_waitcnt lgkmcnt(0)" ::: "memory"); SBAR(); \
    _Pragma("unroll") for (int d0 = 0; d0 < 4; ++d0) P = __builtin_amdgcn_mfma_f32_32x32x16_bf16(kf[d0], qr[d0], P, 0, 0, 0); \
    SBAR(); \
    _Pragma("unroll") for (int d0 = 0; d0 < 4; ++d0) kf[d0] = *reinterpret_cast<const bf16x8*>(K_lds + (b) * SHM_K + KSWZ(krow, ((d0 + 4) * 16 + hi * 8) * 2)); \
    asm volatile("s_waitcnt lgkmcnt(0)" ::: "memory"); SBAR(); \
    _Pragma("unroll") for (int d0 = 0; d0 < 4; ++d0) P = __builtin_amdgcn_mfma_f32_32x32x16_bf16(kf[d0], qr[d0 + 4], P, 0, 0, 0); } while (0)
#define PROWMAX(P, PM) do { PM = P[0]; _Pragma("unroll") for (int r = 1; r < 16; ++r) PM = fmaxf(PM, P[r]); \
    { auto rr = __builtin_amdgcn_permlane32_swap(__float_as_uint(PM), __float_as_uint(PM), false, false); PM = fmaxf(__uint_as_float(rr[0]), __uint_as_float(rr[1])); } \
    if (hi == 0) mx_l[r32] = PM; } while (0)
#define PSTEP(B, j, PC, PMC, PN, PMN) do { constexpr float C = SCALE * 1.4426950408889634f; \
      \
    SBAR(); PQKT(PN, 1 - (B)); \
    float pmax = fmaxf(PMC, pwsf[64 + r32]); \
    float mn, alpha; \
    if (__builtin_expect(__all(pmax - m_reg <= THR / SCALE), 1)) { mn = m_reg; alpha = 1.f; } \
    else { mn = fmaxf(m_reg, pmax); alpha = __builtin_amdgcn_exp2f((m_reg - mn) * C); m_reg = mn; } \
    const float mnC = -mn * C; \
    _Pragma("unroll") for (int r = 0; r < 16; ++r) PC[r] = __builtin_amdgcn_exp2f(fmaf(PC[r], C, mnC)); \
    float ps = 0; _Pragma("unroll") for (int r = 0; r < 16; ++r) ps += PC[r]; \
    { auto rr = __builtin_amdgcn_permlane32_swap(__float_as_uint(ps), __float_as_uint(ps), false, false); ps = __uint_as_float(rr[0]) + __uint_as_float(rr[1]); } \
    l_reg = l_reg * alpha + ps; \
    u32x4 f0, f1; PK4(PC, 0, f0); PK4(PC, 8, f1); pex_own[0] = f0; pex_own[64] = f1; \
    const bool resc = __any(alpha < 1.f); if (resc && hi == 0) al_l[r32] = alpha; \
    asm volatile("s_waitcnt vmcnt(8)" ::: "memory"); PWRITEV(1 - (B), 1 - (B)); PLOADV(1 - (B), (j) + 3); \
    asm volatile("s_waitcnt lgkmcnt(0)" ::: "memory"); __syncthreads();              \
      \
    const u32x4 g0 = pex_par[0], g1 = pex_par[64]; \
    if (resc) { _Pragma("unroll") for (int d = 0; d < 4; ++d) _Pragma("unroll") for (int r = 0; r < 16; ++r) o[d][r] *= al_l[crow(r, hi)]; } \
    const u32x4 q0 = ph ? g0 : f0, q1 = ph ? g1 : f1, q2 = ph ? f0 : g0, q3 = ph ? f1 : g1; \
    SBAR(); pv_d0(o, vb0 + (B) * 2 * (int)SHM_V, __builtin_bit_cast(bf16x8, q0), __builtin_bit_cast(bf16x8, q1), __builtin_bit_cast(bf16x8, q2), __builtin_bit_cast(bf16x8, q3)); \
    asm volatile("s_waitcnt vmcnt(10)" ::: "memory"); PWRITEK(B, B); PLOADK(B, (j) + 4); \
    PROWMAX(PN, PMN); \
    asm volatile("s_waitcnt lgkmcnt(0)" ::: "memory"); __syncthreads();              \
  } while (0)
  f32x16 pA, pB; float pmA, pmB;
  PLOADK(0, 0); PLOADV(0, 0); PLOADK(1, 1); asm volatile("s_waitcnt vmcnt(0)" ::: "memory"); PWRITEK(0, 0); PWRITEV(0, 0); PWRITEK(1, 1);
  PLOADV(1, 1); PLOADK(0, 2); PLOADV(0, 2); PLOADK(1, 3);
  asm volatile("s_waitcnt lgkmcnt(0)" ::: "memory"); __syncthreads();
  PQKT(pA, 0); PROWMAX(pA, pmA); pB = f32x16{}; pmB = 0.f;
  asm volatile("s_waitcnt lgkmcnt(0)" ::: "memory"); __syncthreads();
#pragma unroll 1
  for (int j = 0; j < NT; j += 2) { PSTEP(0, j, pA, pmA, pB, pmB); PSTEP(1, j + 1, pB, pmB, pA, pmA); }
  if (hi == 0) li_l[r32] = l_reg; asm volatile("s_waitcnt lgkmcnt(0)" ::: "memory"); __syncthreads();
  float rli[16];
#pragma unroll
  for (int r = 0; r < 16; ++r) rli[r] = __builtin_amdgcn_rcpf(li_l[crow(r, hi)] + pwsf[crow(r, hi)]);
  bf16_t* Ow = Ob + (long)(pw * QBLK) * LD + ph * 128;
#pragma unroll
  for (int r = 0; r < 16; ++r) { int orow = crow(r, hi);
#pragma unroll
    for (int d0 = 0; d0 < 4; ++d0) Ow[(long)orow * LD + d0 * 32 + r32] = (bf16_t)f2bf(o[d0][r] * rli[r]); }
  __syncthreads();
#undef PLOADK
#undef PLOADV
#undef PWRITEK
#undef PWRITEV
#undef PK4
#undef PQKT
#undef PROWMAX
#undef PSTEP
}
}

namespace scan {
constexpr int PQ = 272, PT = 80;
constexpr int OFF_QH = 0, OFF_KT = 8704, OFF_KTT = 17408, OFF_VT = 27648, OFF_EBL = 37888, BUF = 38400;
static_assert(2 * BUF <= MISC_OFF, "scan LDS map");
constexpr float LOG2E = 1.4426950408889634f;
struct Ld { f32x2 lf[8]; unsigned q[8], k[8], v[8]; };
__device__ __forceinline__ int seq_row(int b, int dir, int s) { return b * TPB + (dir == 0 ? s : (s < CTXL ? (CTXL - 1 - s) : (TPB + CTXL - 1 - s))); }

__device__ __forceinline__ void scan_unit(LAS unsigned char* lds, const bf16_t* Q, const bf16_t* Kd, const _Float16* LFd, const bf16_t* V, bf16_t* Od, int b, int h, int dir) {
    int tid_ = threadIdx.x; asm volatile("" : "+v"(tid_));
    const int tid = tid_, lane = tid & 63, wv = __builtin_amdgcn_readfirstlane(tid >> 6);
    constexpr int NBLK = TPB / 32;
    const int rs_ = dir == 0 ? 2048 : -2048;
    if (wv >= 4) {
        const int dp = 16 * (wv - 4) + (lane & 15), tg = lane >> 4;
        Ld ra, rb;
#define SCAN_LOAD(R, blk) do { const long o0_ = (long)seq_row(b, dir, (blk) * 32 + 8 * tg) * 2048 + h * 128 + 2 * dp; \
        _Pragma("unroll") for (int i = 0; i < 8; ++i) { const long o_ = o0_ + (long)i * rs_; { typedef _Float16 h2 __attribute__((ext_vector_type(2))); const h2 l_ = *(const h2*)(LFd + o_); R.lf[i] = (f32x2){(float)l_[0], (float)l_[1]}; } R.q[i] = *(const unsigned*)(Q + o_); R.k[i] = *(const unsigned*)(Kd + o_); R.v[i] = *(const unsigned*)(V + o_); } } while (0)
#define SCAN_PREP(R, bufb) do { f32x2 cs[8]; cs[0] = R.lf[0]; _Pragma("unroll") for (int i = 1; i < 8; ++i) cs[i] = cs[i - 1] + R.lf[i]; \
        f32x2 pre = (f32x2){0.f, 0.f}, tot = (f32x2){0.f, 0.f}; \
        _Pragma("unroll") for (int g = 0; g < 4; ++g) { f32x2 t_; t_.x = __shfl(cs[7].x, (lane & 15) + 16 * g); t_.y = __shfl(cs[7].y, (lane & 15) + 16 * g); tot += t_; if (g < tg) pre += t_; } \
        unsigned ktp[8]; \
        _Pragma("unroll") for (int i = 0; i < 8; ++i) { const int tk = 8 * tg + i; const f32x2 bc = (pre + cs[i]) * LOG2E; \
            const float e0 = __builtin_amdgcn_exp2f(bc.x), e1 = __builtin_amdgcn_exp2f(bc.y), i0 = __builtin_amdgcn_exp2f(-bc.x), i1 = __builtin_amdgcn_exp2f(-bc.y); \
            *(LAS unsigned*)((bufb) + OFF_QH + tk * PQ + dp * 4) = cvt_pk_bf16(bf2f(R.q[i] & 0xffffu) * e0, bf2f(R.q[i] >> 16) * e1); \
            ktp[i] = cvt_pk_bf16(bf2f(R.k[i] & 0xffffu) * i0, bf2f(R.k[i] >> 16) * i1); \
            *(LAS unsigned*)((bufb) + OFF_KT + tk * PQ + dp * 4) = ktp[i]; } \
        u32x4 w_; \
        w_.x = (ktp[0] & 0xffffu) | (ktp[1] << 16); w_.y = (ktp[2] & 0xffffu) | (ktp[3] << 16); w_.z = (ktp[4] & 0xffffu) | (ktp[5] << 16); w_.w = (ktp[6] & 0xffffu) | (ktp[7] << 16); *(LAS u32x4*)((bufb) + OFF_KTT + (2 * dp) * PT + tg * 16) = w_; \
        w_.x = (ktp[0] >> 16) | (ktp[1] & 0xffff0000u); w_.y = (ktp[2] >> 16) | (ktp[3] & 0xffff0000u); w_.z = (ktp[4] >> 16) | (ktp[5] & 0xffff0000u); w_.w = (ktp[6] >> 16) | (ktp[7] & 0xffff0000u); *(LAS u32x4*)((bufb) + OFF_KTT + (2 * dp + 1) * PT + tg * 16) = w_; \
        w_.x = (R.v[0] & 0xffffu) | (R.v[1] << 16); w_.y = (R.v[2] & 0xffffu) | (R.v[3] << 16); w_.z = (R.v[4] & 0xffffu) | (R.v[5] << 16); w_.w = (R.v[6] & 0xffffu) | (R.v[7] << 16); *(LAS u32x4*)((bufb) + OFF_VT + (2 * dp) * PT + tg * 16) = w_; \
        w_.x = (R.v[0] >> 16) | (R.v[1] & 0xffff0000u); w_.y = (R.v[2] >> 16) | (R.v[3] & 0xffff0000u); w_.z = (R.v[4] >> 16) | (R.v[5] & 0xffff0000u); w_.w = (R.v[6] >> 16) | (R.v[7] & 0xffff0000u); *(LAS u32x4*)((bufb) + OFF_VT + (2 * dp + 1) * PT + tg * 16) = w_; \
        if (tg == 0) *(LAS f32x2*)((bufb) + OFF_EBL + dp * 8) = (f32x2){__builtin_amdgcn_exp2f(tot.x * LOG2E), __builtin_amdgcn_exp2f(tot.y * LOG2E)}; } while (0)
        SCAN_LOAD(ra, 0); SCAN_LOAD(rb, 1);
        SCAN_PREP(ra, lds); SCAN_LOAD(ra, 2);
        LDS_WAIT(); __syncthreads();
        for (int n = 0; n < NBLK; n += 2) {
            if (n + 1 < NBLK) { SCAN_PREP(rb, lds + BUF); } SCAN_LOAD(rb, (n + 3 < NBLK ? n + 3 : NBLK - 1));
            LDS_WAIT(); __syncthreads();
            if (n + 2 < NBLK) { SCAN_PREP(ra, lds); } SCAN_LOAD(ra, (n + 4 < NBLK ? n + 4 : NBLK - 1));
            LDS_WAIT(); __syncthreads();
        }
#undef SCAN_LOAD
#undef SCAN_PREP
    } else {
        const int c16 = lane & 15, q4 = lane >> 4;
        f32x4 S[2][8];
#pragma unroll
        for (int ct = 0; ct < 2; ++ct)
#pragma unroll
            for (int t = 0; t < 8; ++t) S[ct][t] = (f32x4){0.f, 0.f, 0.f, 0.f};
        __syncthreads();
#pragma unroll 1
        for (int n = 0; n < NBLK; ++n) {
            LAS unsigned char* bc_ = lds + (n & 1) * BUF;
            f32x4 c00 = (f32x4){0.f, 0.f, 0.f, 0.f}, c01 = c00, c11 = c00;
#pragma unroll
            for (int ks = 0; ks < 4; ++ks) {
                const bf16x8 k0 = *(const LAS bf16x8*)(bc_ + OFF_KT + c16 * PQ + (32 * ks + 8 * q4) * 2), k1 = *(const LAS bf16x8*)(bc_ + OFF_KT + (16 + c16) * PQ + (32 * ks + 8 * q4) * 2);
                const bf16x8 q0 = *(const LAS bf16x8*)(bc_ + OFF_QH + c16 * PQ + (32 * ks + 8 * q4) * 2), q1 = *(const LAS bf16x8*)(bc_ + OFF_QH + (16 + c16) * PQ + (32 * ks + 8 * q4) * 2);
                c00 = __builtin_amdgcn_mfma_f32_16x16x32_bf16(k0, q0, c00, 0, 0, 0); c01 = __builtin_amdgcn_mfma_f32_16x16x32_bf16(k0, q1, c01, 0, 0, 0); c11 = __builtin_amdgcn_mfma_f32_16x16x32_bf16(k1, q1, c11, 0, 0, 0); }
#pragma unroll
            for (int r = 0; r < 4; ++r) if (4 * q4 + r > c16) { c00[r] = 0.f; c11[r] = 0.f; }
            u32x4 a0w, a1w; a0w.x = cvt_pk_bf16(c00[0], c00[1]); a0w.y = cvt_pk_bf16(c00[2], c00[3]); a0w.z = 0u; a0w.w = 0u;
            a1w.x = cvt_pk_bf16(c01[0], c01[1]); a1w.y = cvt_pk_bf16(c01[2], c01[3]); a1w.z = cvt_pk_bf16(c11[0], c11[1]); a1w.w = cvt_pk_bf16(c11[2], c11[3]);
            f32x4 o0[2], o1[2];
#pragma unroll
            for (int ct = 0; ct < 2; ++ct) { const int dv = 32 * wv + 16 * ct + c16;
                u32x4 bvw; { const u32x2 lo = *(const LAS u32x2*)(bc_ + OFF_VT + dv * PT + (4 * q4) * 2), hi_ = *(const LAS u32x2*)(bc_ + OFF_VT + dv * PT + (16 + 4 * q4) * 2); bvw.x = lo.x; bvw.y = lo.y; bvw.z = hi_.x; bvw.w = hi_.y; }
                o0[ct] = __builtin_amdgcn_mfma_f32_16x16x32_bf16(__builtin_bit_cast(bf16x8, a0w), __builtin_bit_cast(bf16x8, bvw), (f32x4){0.f, 0.f, 0.f, 0.f}, 0, 0, 0);
                o1[ct] = __builtin_amdgcn_mfma_f32_16x16x32_bf16(__builtin_bit_cast(bf16x8, a1w), __builtin_bit_cast(bf16x8, bvw), (f32x4){0.f, 0.f, 0.f, 0.f}, 0, 0, 0); }
#pragma unroll
            for (int ks = 0; ks < 4; ++ks) {
                u32x4 q0w, q1w; { const u32x2 l0 = *(const LAS u32x2*)(bc_ + OFF_QH + c16 * PQ + (32 * ks + 4 * q4) * 2), h0 = *(const LAS u32x2*)(bc_ + OFF_QH + c16 * PQ + (32 * ks + 16 + 4 * q4) * 2);
                    const u32x2 l1 = *(const LAS u32x2*)(bc_ + OFF_QH + (16 + c16) * PQ + (32 * ks + 4 * q4) * 2), h1 = *(const LAS u32x2*)(bc_ + OFF_QH + (16 + c16) * PQ + (32 * ks + 16 + 4 * q4) * 2);
                    q0w.x = l0.x; q0w.y = l0.y; q0w.z = h0.x; q0w.w = h0.y; q1w.x = l1.x; q1w.y = l1.y; q1w.z = h1.x; q1w.w = h1.y; }
#pragma unroll
                for (int ct = 0; ct < 2; ++ct) {
                    u32x4 sw; sw.x = cvt_pk_bf16(S[ct][2 * ks][0], S[ct][2 * ks][1]); sw.y = cvt_pk_bf16(S[ct][2 * ks][2], S[ct][2 * ks][3]); sw.z = cvt_pk_bf16(S[ct][2 * ks + 1][0], S[ct][2 * ks + 1][1]); sw.w = cvt_pk_bf16(S[ct][2 * ks + 1][2], S[ct][2 * ks + 1][3]);
                    o0[ct] = __builtin_amdgcn_mfma_f32_16x16x32_bf16(__builtin_bit_cast(bf16x8, q0w), __builtin_bit_cast(bf16x8, sw), o0[ct], 0, 0, 0);
                    o1[ct] = __builtin_amdgcn_mfma_f32_16x16x32_bf16(__builtin_bit_cast(bf16x8, q1w), __builtin_bit_cast(bf16x8, sw), o1[ct], 0, 0, 0); } }
#pragma unroll
            for (int ct = 0; ct < 2; ++ct) { bf16_t* op_ = Od + (size_t)seq_row(b, dir, n * 32 + 4 * q4) * 2048 + h * 128 + 32 * wv + 16 * ct + c16;
#pragma unroll
                for (int r = 0; r < 4; ++r) { op_[(long)r * rs_] = (bf16_t)f2bf(o0[ct][r]); op_[(long)(16 + r) * rs_] = (bf16_t)f2bf(o1[ct][r]); } }
            { bf16x8 bv2[2];
#pragma unroll
              for (int ct = 0; ct < 2; ++ct) bv2[ct] = *(const LAS bf16x8*)(bc_ + OFF_VT + (32 * wv + 16 * ct + c16) * PT + q4 * 16);
#pragma unroll
              for (int t = 0; t < 8; ++t) { const bf16x8 ak = *(const LAS bf16x8*)(bc_ + OFF_KTT + (16 * t + c16) * PT + q4 * 16);
                  S[0][t] = __builtin_amdgcn_mfma_f32_16x16x32_bf16(ak, bv2[0], S[0][t], 0, 0, 0); S[1][t] = __builtin_amdgcn_mfma_f32_16x16x32_bf16(ak, bv2[1], S[1][t], 0, 0, 0); }
#pragma unroll
              for (int t = 0; t < 8; ++t) { const f32x4 e = *(const LAS f32x4*)(bc_ + OFF_EBL + (16 * t + 4 * q4) * 4); S[0][t] *= e; S[1][t] *= e; } }
            LDS_WAIT(); __syncthreads();
        }
    }
}
}

struct Args { const float* in[18]; float* out; unsigned char* ws; int ph_lo, ph_hi; };

struct Frame {
    LAS unsigned char* lds; unsigned char* ws; const float* const* in;
    int tid, lane, wave, G, bx, vcu;
};

template <bool ROPE_PERM>
__device__ __forceinline__ void transpose_item(const float* W, int K, int N, bf16_t* WT, LAS float* scr, int item, int lane) {
    const int nblk = N / 32, kb = item / nblk, nb = item % nblk, k0 = 64 * kb, n0 = 32 * nb;
#pragma unroll 8
    for (int i = 0; i < 32; ++i) { const int kk = 2 * i + (lane >> 5); scr[kk * 33 + (lane & 31)] = W[(size_t)(k0 + kk) * N + n0 + (lane & 31)]; }
    LDS_WAIT(); asm volatile("" ::: "memory");
    const int c = lane & 7;
#pragma unroll
    for (int j = 0; j < 4; ++j) { const int n = (lane >> 3) + 8 * j; const LAS float* s = scr + (8 * c) * 33 + n;
        u32x4 o; o.x = f2bf(s[0 * 33]) | (f2bf(s[1 * 33]) << 16); o.y = f2bf(s[2 * 33]) | (f2bf(s[3 * 33]) << 16); o.z = f2bf(s[4 * 33]) | (f2bf(s[5 * 33]) << 16); o.w = f2bf(s[6 * 33]) | (f2bf(s[7 * 33]) << 16);
        int nn = n0 + n;
        if (ROPE_PERM) { if (nn < 4096) { const int d = nn & 127, base = nn - d; nn = base + (d < 64 ? 2 * d : 2 * (d - 64) + 1); } }
        *(GAS u32x4*)(WT + (size_t)nn * K + k0 + 8 * c) = o; }
    LDS_WAIT(); asm volatile("" ::: "memory");
}

#define FRAME_OPAQUE(F) do { int t_ = threadIdx.x; asm volatile("" : "+v"(t_)); (F).tid = t_; (F).lane = t_ & 63; } while (0)
__device__ __forceinline__ void p0_prologue(Frame& F) {
    FRAME_OPAQUE(F);
    const float* const* in = F.in; unsigned char* ws = F.ws;
    {
        LAS float* scr = (LAS float*)(F.lds + F.wave * 16384);
        const int gw = F.bx * NWAVES + F.wave, NGW = F.G * NWAVES;
        constexpr int I_W1 = (DM / 64) * (HID / 32), I_W2 = (HID / 64) * (DM / 32), I_SQ = (DM / 64) * (DM / 32), I_HIN = (DM / 64) * (10240 / 32), I_QKV = (DM / 64) * (6144 / 32);
        constexpr int NIT = 4 * I_W1 + 4 * I_W2 + 4 * I_SQ + I_HIN + I_QKV;
        for (int it = gw; it < NIT; it += NGW) {
            int r = it;
            if (r < 4 * I_W1) { const int l = r / I_W1; transpose_item<false>(in[7] + (size_t)l * DM * HID, DM, HID, (bf16_t*)(ws + WS_W1T) + (size_t)l * DM * HID, scr, r % I_W1, F.lane); continue; } r -= 4 * I_W1;
            if (r < 4 * I_W2) { const int l = r / I_W2; transpose_item<false>(in[8] + (size_t)l * DM * HID, HID, DM, (bf16_t*)(ws + WS_W2T) + (size_t)l * DM * HID, scr, r % I_W2, F.lane); continue; } r -= 4 * I_W2;
            if (r < 2 * I_SQ) { const int l = r / I_SQ; transpose_item<false>(in[9] + (size_t)l * DM * DM, DM, DM, (bf16_t*)(ws + WS_FWO) + (size_t)l * DM * DM, scr, r % I_SQ, F.lane); continue; } r -= 2 * I_SQ;
            if (r < I_SQ) { transpose_item<false>(in[13], DM, DM, (bf16_t*)(ws + WS_HWO), scr, r, F.lane); continue; } r -= I_SQ;
            if (r < I_SQ) { transpose_item<false>(in[17], DM, DM, (bf16_t*)(ws + WS_DWO), scr, r, F.lane); continue; } r -= I_SQ;
            if (r < I_HIN) { transpose_item<false>(in[10], DM, 10240, (bf16_t*)(ws + WS_HWIN), scr, r, F.lane); continue; } r -= I_HIN;
            transpose_item<true>(in[14], DM, 6144, (bf16_t*)(ws + WS_DQKV), scr, r, F.lane);
        }
    }
    __syncthreads();
    {
        const size_t gt = (size_t)F.bx * NTHR + F.tid, NT_ = (size_t)F.G * NTHR;
        bf16_t* CS = (bf16_t*)(ws + WS_CS);
        for (size_t e = gt; e < (size_t)2048 * 2048 / 2; e += NT_) {
            const int r = (int)(e / 1024), l = (int)(e % 1024) * 2; const int rr = r & 1023;
            const float x0 = (float)((rr * l) & 2047) * (1.f / 1024.f), x1 = (float)((rr * (l + 1)) & 2047) * (1.f / 1024.f);
            float v0 = r < 1024 ? cospif(x0) : sinpif(x0), v1 = r < 1024 ? cospif(x1) : sinpif(x1);
            if (r == 1024) { v0 = 1.f; v1 = -1.f; }
            *(unsigned*)(CS + (size_t)r * 2048 + l) = cvt_pk_bf16(v0, v1);
        }
        bf16_t* C2 = (bf16_t*)(ws + WS_CS256);
        for (size_t e = gt; e < (size_t)512 * 256 / 2; e += NT_) {
            const int r = (int)(e / 128), l = (int)(e % 128) * 2; const int rr = r & 255;
            const float x0 = (float)((rr * l) & 255) * (1.f / 128.f), x1 = (float)((rr * (l + 1)) & 255) * (1.f / 128.f);
            const float v0 = r < 256 ? cospif(x0) : sinpif(x0), v1 = r < 256 ? cospif(x1) : sinpif(x1);
            *(unsigned*)(C2 + (size_t)r * 2048 + l) = cvt_pk_bf16(v0, v1);
        }
        bf16_t* CC = (bf16_t*)(ws + WS_CC);
        for (size_t e = gt; e < (size_t)1024 * 512 / 2; e += NT_) {
            const int j = (int)(e / 256), k = (int)(e % 256) * 2; const int kk = k & 255, cp = j & 255;
            const float x0 = (float)((cp * kk) & 255) * (1.f / 128.f), x1 = (float)((cp * (kk + 1)) & 255) * (1.f / 128.f);
            float v0, v1;
            if (j < 512) { const float sg = j < 256 ? -1.f : 1.f; v0 = k < 256 ? cospif(x0) : sg * sinpif(x0); v1 = k < 256 ? cospif(x1) : sg * sinpif(x1); }
            else { const bool on = ((j - 512) < 256) == (k < 256); v0 = on ? cospif(x0) : 0.f; v1 = on ? cospif(x1) : 0.f; }
            *(unsigned*)(CC + (size_t)j * 512 + k) = cvt_pk_bf16(v0, v1);
        }
        float* rc = (float*)(ws + WS_ROPE); float* rs = rc + 2048 * 64;
        for (size_t e = gt; e < (size_t)2048 * 64; e += NT_) {
            const int pos = (int)(e >> 6), i = (int)(e & 63);
            const float inv = powf(10000.f, -(float)(i & 31) / 32.f);
            const float ang = (float)(i < 32 ? (pos >> 6) : (pos & 63)) * inv;
            rc[e] = cosf(ang); rs[e] = sinf(ang);
        }
        float* lb = (float*)(ws + WS_LB); const float* p = in[11];
        for (size_t e = gt; e < (size_t)2 * 2048; e += NT_) {
            const float a0 = p[e], a1 = p[4096 + e], a2 = p[8192 + e], a3 = p[12288 + e];
            const float mx = fmaxf(fmaxf(a0, a1), fmaxf(a2, a3));
            const float e0 = expf(a0 - mx), e1 = expf(a1 - mx), e2 = expf(a2 - mx), e3 = expf(a3 - mx);
            lb[e] = e1 / (e0 + e1 + e2 + e3);
        }
    }
    {
        LAS float* sS = (LAS float*)F.lds;
        for (int e = F.tid; e < 2048; e += NTHR) {
#pragma unroll
            for (int r = 0; r < 5; ++r) { const float c = r < 4 ? in[1][r * 2048 + e] : in[3][e]; sS[e * 8 + r] = c / (1.f + __expf(-c)); }
        }
        LDS_WAIT(); __syncthreads();
        for (int cb = F.bx; cb < 256; cb += F.G) {
            const int col0 = cb * 192;
            const int layer = col0 / 12288, n0 = col0 % 12288;
            const float* W = in[4] + (size_t)layer * DM * 12288 + n0;
            f32x4 a[5];
#pragma unroll
            for (int r = 0; r < 5; ++r) a[r] = (f32x4){0.f, 0.f, 0.f, 0.f};
            if (F.lane < 48) {
                const int kb = F.wave * 256;
#pragma unroll 16
                for (int k = 0; k < 256; ++k) {
                    const f32x4 w = __builtin_nontemporal_load((const f32x4*)(W + (size_t)(kb + k) * 12288 + 4 * F.lane));
                    const f32x4 s4 = *(const LAS f32x4*)(sS + (kb + k) * 8); const float s5 = sS[(kb + k) * 8 + 4];
                    a[0] += w * s4[0]; a[1] += w * s4[1]; a[2] += w * s4[2]; a[3] += w * s4[3]; a[4] += w * s5;
                }
            }
            __syncthreads();
            LAS float* red = (LAS float*)(F.lds + 65536);
            if (F.lane < 48) {
#pragma unroll
                for (int r = 0; r < 5; ++r) *(LAS f32x4*)(red + (F.wave * 5 + r) * 192 + 4 * F.lane) = a[r];
            }
            LDS_WAIT(); __syncthreads();
            float* MOD = (float*)(ws + WS_MOD);
            for (int e = F.tid; e < 5 * 192; e += NTHR) { const int r = e / 192, n = e % 192; float s = 0.f;
#pragma unroll
                for (int w8 = 0; w8 < 8; ++w8) s += red[(w8 * 5 + r) * 192 + n];
                MOD[((size_t)layer * 5 + r) * 12288 + n0 + n] = s + in[5][layer * 12288 + n0 + n]; }
        }
        __syncthreads();
    }
}

__device__ __forceinline__ int mod_row(int row) { const int b = row / TPB; return (row - b * TPB) < CTXL ? 4 : b; }
__device__ __forceinline__ float sumsq8(const f32x4 (&v)[8]) { float s = 0.f;
#pragma unroll
    for (int j = 0; j < 8; ++j) s += (v[j][0] * v[j][0] + v[j][1] * v[j][1]) + (v[j][2] * v[j][2] + v[j][3] * v[j][3]);
    return wave_sum(s); }

__device__ __forceinline__ void norm_mod(const f32x4 (&x)[8], const float* g, const float* sh, const float* sc, int lane, u32x2 (&hp)[8]) {
    const float rs = rsqrtf(sumsq8(x) * (1.f / DM) + NORM_EPS);
#pragma unroll
    for (int j = 0; j < 8; ++j) { const int c = 4 * lane + 256 * j; const f32x4 gv = *(const f32x4*)(g + c), shv = *(const f32x4*)(sh + c), scv = *(const f32x4*)(sc + c);
        const f32x4 hv = (x[j] * rs) * gv * (scv + 1.f) + shv; hp[j].x = cvt_pk_bf16(hv[0], hv[1]); hp[j].y = cvt_pk_bf16(hv[2], hv[3]); }
}
template <int MODE>
__device__ __forceinline__ void row_phase(Frame& F, int layer, bool latonly, bool tr, float* dout, bool splitk) {
    FRAME_OPAQUE(F);
    unsigned char* ws = F.ws; const float* const* in = F.in;
    typedef _Float16 h4 __attribute__((ext_vector_type(4)));
    _Float16* X = (_Float16*)(ws + WS_X); const bf16_t* YO = (const bf16_t*)(ws + WS_YO); bf16_t* H = (bf16_t*)(ws + WS_H);
    const float* MOD = (const float*)(ws + WS_MOD); const float* ng = in[6];
    const int nextl = MODE == 2 ? layer + 1 : layer;
    const int nlat = NBATCH * SEQ / 32;
    const bool deal_ctx = !latonly && !tr, ctx2 = !latonly && tr;
    LAS unsigned* T = (LAS unsigned*)F.lds;
    for (int it = F.bx; it < nlat; it += F.G) {
        const int ib = it / (SEQ / 32), ip0 = (it % (SEQ / 32)) * 32;
        LAS f32x4* VL = (LAS f32x4*)F.lds;
        if (!tr) {
            __syncthreads();
            const float* gg_ = ng + (layer * 4 + (MODE == 1 ? 1 : 3)) * DM; const float* g2_ = ng + ((nextl < DEPTH ? nextl : 0) * 4 + (MODE == 1 ? 2 : 0)) * DM;
            const float* m0_ = MOD + ((size_t)layer * 5 + ib) * 12288; const float* m1_ = MOD + ((size_t)(nextl < DEPTH ? nextl : 0) * 5 + ib) * 12288;
            const float* c0_ = MOD + ((size_t)layer * 5 + 4) * 12288; const float* c1_ = MOD + ((size_t)(nextl < DEPTH ? nextl : 0) * 5 + 4) * 12288;
            const int t4 = 4 * F.tid;
            if (MODE != 0) { VL[F.tid] = *(const f32x4*)(gg_ + t4); VL[2 * 512 + F.tid] = *(const f32x4*)(m0_ + (MODE == 1 ? 2 : 5) * DM + t4); VL[5 * 512 + F.tid] = *(const f32x4*)(c0_ + (MODE == 1 ? 2 : 5) * DM + t4); }
            VL[512 + F.tid] = *(const f32x4*)(g2_ + t4);
            VL[3 * 512 + F.tid] = *(const f32x4*)(m1_ + (MODE == 1 ? 3 : 0) * DM + t4); VL[4 * 512 + F.tid] = *(const f32x4*)(m1_ + (MODE == 1 ? 4 : 1) * DM + t4);
            VL[6 * 512 + F.tid] = *(const f32x4*)(c1_ + (MODE == 1 ? 3 : 0) * DM + t4); VL[7 * 512 + F.tid] = *(const f32x4*)(c1_ + (MODE == 1 ? 4 : 1) * DM + t4);
            LDS_WAIT(); __syncthreads();
        }
#pragma unroll 1
      for (int pass = 0; pass < (ctx2 ? 2 : 1); ++pass) {
        const int q0 = pass ? 4 : 0, nq = pass ? (F.wave < 4 ? 5 : 4) : 4 + ((deal_ctx && F.wave < 4) ? 1 : 0);
        u32x2 ybn[8]; h4 xvn[8];
        if (MODE != 0 && q0 == 0) { const size_t r0_ = (size_t)(ib * TPB + CTXL + ip0 + F.wave * 4) * DM + 4 * F.lane;
#pragma unroll
            for (int j = 0; j < 8; ++j) { ybn[j] = *(const u32x2*)(YO + r0_ + 256 * j); xvn[j] = *(const h4*)(X + r0_ + 256 * j); } }
#pragma unroll 1
        for (int q = q0; q < nq; ++q) {
            int b = ib, isctx = 0, pos = ip0 + F.wave * 4 + q;
            const int rl = pass ? F.wave : F.wave * 4 + q;
            if (q == 4) { const int cr = 4 * it + F.wave; b = cr / CTXL; pos = cr % CTXL; isctx = 1; }
            const int row = b * TPB + (isctx ? 0 : CTXL) + pos;
            const int mr = isctx ? 4 : b;
            f32x4 x[8];
            if (MODE == 0) {
                const float* src = isctx ? in[2] + ((size_t)b * CTXL + pos) * DM : in[0] + ((size_t)b * SEQ + pos) * DM;
#pragma unroll
                for (int j = 0; j < 8; ++j) x[j] = *(const f32x4*)(src + 4 * F.lane + 256 * j);
            } else {
                f32x4 y[8], xc[8];
                if (q < 4) {
#pragma unroll
                    for (int j = 0; j < 8; ++j) { y[j] = (f32x4){bf2f(ybn[j].x & 0xffffu), bf2f(ybn[j].x >> 16), bf2f(ybn[j].y & 0xffffu), bf2f(ybn[j].y >> 16)}; xc[j] = __builtin_convertvector(xvn[j], f32x4); }
                    { const size_t r1_ = (size_t)(q + 1 < 4 ? row + 1 : row) * DM + 4 * F.lane;
#pragma unroll
                        for (int j = 0; j < 8; ++j) { ybn[j] = *(const u32x2*)(YO + r1_ + 256 * j); xvn[j] = *(const h4*)(X + r1_ + 256 * j); } }
                } else {
#pragma unroll
                    for (int j = 0; j < 8; ++j) xc[j] = __builtin_convertvector(*(const h4*)(X + (size_t)row * DM + 4 * F.lane + 256 * j), f32x4);
                if (splitk && isctx) {
                    const bf16_t* sl = (const bf16_t*)(ws + WS_SLAB) + ((size_t)b * CTXL + pos) * DM + 4 * F.lane;
#pragma unroll
                    for (int j = 0; j < 8; ++j) y[j] = (f32x4){0.f, 0.f, 0.f, 0.f};
#pragma unroll 2
                    for (int k = 0; k < 8; ++k) {
#pragma unroll
                        for (int j = 0; j < 8; ++j) { const u32x2 yb = *(const u32x2*)(sl + 256 * j); y[j] += (f32x4){bf2f(yb.x & 0xffffu), bf2f(yb.x >> 16), bf2f(yb.y & 0xffffu), bf2f(yb.y >> 16)}; }
                        sl += SLAB_BYTES / 2; }
                } else {
#pragma unroll
                    for (int j = 0; j < 8; ++j) { const u32x2 yb = *(const u32x2*)(YO + (size_t)row * DM + 4 * F.lane + 256 * j);
                        y[j] = (f32x4){bf2f(yb.x & 0xffffu), bf2f(yb.x >> 16), bf2f(yb.y & 0xffffu), bf2f(yb.y >> 16)}; }
                }
                }
                const float rs = rsqrtf(sumsq8(y) * (1.f / DM) + NORM_EPS);
                const float* gg = ng + (layer * 4 + (MODE == 1 ? 1 : 3)) * DM; const float* gate = MOD + ((size_t)layer * 5 + mr) * 12288 + (MODE == 1 ? 2 : 5) * DM;
#pragma unroll
                for (int j = 0; j < 8; ++j) { const int c = 4 * F.lane + 256 * j; const f32x4 xv = xc[j];
                    const f32x4 gv = tr ? *(const f32x4*)(gg + c) : VL[F.lane + 64 * j], gt = tr ? *(const f32x4*)(gate + c) : VL[(isctx ? 5 : 2) * 512 + F.lane + 64 * j];
                    x[j] = xv + gt * ((y[j] * rs) * gv); }
            }
            if (dout) {
                float* o = dout + ((size_t)b * SEQ + pos) * DM;
#pragma unroll
                for (int j = 0; j < 8; ++j) *(f32x4*)(o + 4 * F.lane + 256 * j) = x[j];
            } else {
#pragma unroll
                for (int j = 0; j < 8; ++j) *(h4*)(X + (size_t)row * DM + 4 * F.lane + 256 * j) = __builtin_convertvector(x[j], h4);
                const float* g2 = ng + (nextl * 4 + (MODE == 1 ? 2 : 0)) * DM;
                const float* sh = MOD + ((size_t)nextl * 5 + mr) * 12288 + (MODE == 1 ? 3 : 0) * DM; const float* sc = sh + DM;
                u32x2 hp[8];
                if (tr) norm_mod(x, g2, sh, sc, F.lane, hp);
                else { const float rs2 = rsqrtf(sumsq8(x) * (1.f / DM) + NORM_EPS); const int so = (isctx ? 6 : 3) * 512;
#pragma unroll
                    for (int j = 0; j < 8; ++j) { const f32x4 gv = VL[512 + F.lane + 64 * j], shv = VL[so + F.lane + 64 * j], scv = VL[so + 512 + F.lane + 64 * j];
                        const f32x4 hv = (x[j] * rs2) * gv * (scv + 1.f) + shv; hp[j].x = cvt_pk_bf16(hv[0], hv[1]); hp[j].y = cvt_pk_bf16(hv[2], hv[3]); } }
                if (!tr) {
#pragma unroll
                    for (int j = 0; j < 8; ++j) *(u32x2*)(H + (size_t)row * DM + 4 * F.lane + 256 * j) = hp[j];
                } else {
#pragma unroll
                    for (int j = 0; j < 8; ++j) { T[rl * 1025 + 2 * F.lane + 128 * j] = hp[j].x; T[rl * 1025 + 2 * F.lane + 128 * j + 1] = hp[j].y; }
                }
            }
        }
        if (tr) {
            LDS_WAIT(); __syncthreads();
            if (pass == 0) {
                bf16_t* HT = (bf16_t*)(ws + SC_HT) + (size_t)ib * 2048 * 2048 + ip0;
                for (int e = F.tid; e < 16 * 1024; e += NTHR) { const int p2 = e & 15, cp = e >> 4;
                    const unsigned a = T[(2 * p2) * 1025 + cp], c = T[(2 * p2 + 1) * 1025 + cp];
                    const unsigned lo = (a & 0xffffu) | (c << 16), hi = (a >> 16) | (c & 0xffff0000u);
                    *(unsigned*)(HT + (size_t)(2 * cp) * 2048 + 2 * p2) = lo; *(unsigned*)(HT + (size_t)(2 * cp + 1) * 2048 + 2 * p2) = hi; }
            } else {
                const int cr0 = 4 * it; bf16_t* HT = (bf16_t*)(ws + SC_HTC) + (size_t)(cr0 / CTXL) * 2048 * 2048 + (cr0 % CTXL);
                for (int cp = F.tid; cp < 1024; cp += NTHR) { const unsigned a0 = T[cp], a1 = T[1025 + cp], a2 = T[2 * 1025 + cp], a3 = T[3 * 1025 + cp];
                    u32x2 lo, hi; lo.x = (a0 & 0xffffu) | (a1 << 16); lo.y = (a2 & 0xffffu) | (a3 << 16); hi.x = (a0 >> 16) | (a1 & 0xffff0000u); hi.y = (a2 >> 16) | (a3 & 0xffff0000u);
                    *(u32x2*)(HT + (size_t)(2 * cp) * 2048) = lo; *(u32x2*)(HT + (size_t)(2 * cp + 1) * 2048) = hi; }
            }
            LDS_WAIT(); __syncthreads();
        }
      }
    }
}

__device__ __forceinline__ void hgrn_readout_phase(Frame& F) {
    FRAME_OPAQUE(F);
    unsigned char* ws = F.ws; const float* gn = F.in[12];
    const bf16_t* O0 = (const bf16_t*)(ws + SC_HO); const bf16_t* O1 = O0 + ACT_ELEMS; const bf16_t* Gs = (const bf16_t*)(ws + SC_HG); bf16_t* Y = (bf16_t*)(ws + WS_ACT);
    const int gw = F.bx * NWAVES + F.wave, NGW = F.G * NWAVES;
    const f32x4 g = *(const f32x4*)(gn + ((4 * F.lane) & 127));
    u32x2 a0n[8], a1n[8], gsn[8];
    if (gw < NROW) {
#pragma unroll
        for (int j = 0; j < 8; ++j) { const size_t off = (size_t)gw * DM + 4 * F.lane + 256 * j; a0n[j] = *(const u32x2*)(O0 + off); a1n[j] = *(const u32x2*)(O1 + off); gsn[j] = *(const u32x2*)(Gs + off); } }
    for (int row = gw; row < NROW; row += NGW) {
        u32x2 a0[8], a1[8], gs[8];
#pragma unroll
        for (int j = 0; j < 8; ++j) { a0[j] = a0n[j]; a1[j] = a1n[j]; gs[j] = gsn[j]; }
        { const int rn_ = row + NGW < NROW ? row + NGW : row;
#pragma unroll
            for (int j = 0; j < 8; ++j) { const size_t off = (size_t)rn_ * DM + 4 * F.lane + 256 * j; a0n[j] = *(const u32x2*)(O0 + off); a1n[j] = *(const u32x2*)(O1 + off); gsn[j] = *(const u32x2*)(Gs + off); } }
#pragma unroll
        for (int j = 0; j < 8; ++j) { const size_t off = (size_t)row * DM + 4 * F.lane + 256 * j;
            const f32x4 o = (f32x4){bf2f(a0[j].x & 0xffffu), bf2f(a0[j].x >> 16), bf2f(a0[j].y & 0xffffu), bf2f(a0[j].y >> 16)} + (f32x4){bf2f(a1[j].x & 0xffffu), bf2f(a1[j].x >> 16), bf2f(a1[j].y & 0xffffu), bf2f(a1[j].y >> 16)};
            float s = (o[0] * o[0] + o[1] * o[1]) + (o[2] * o[2] + o[3] * o[3]);
#pragma unroll
            for (int m = 1; m < 32; m <<= 1) s += __shfl_xor(s, m);
            const float rs = rsqrtf(s * (1.f / 128.f) + NORM_EPS);
            const float y0 = o[0] * rs * g[0] * bf2f(gs[j].x & 0xffffu), y1 = o[1] * rs * g[1] * bf2f(gs[j].x >> 16), y2 = o[2] * rs * g[2] * bf2f(gs[j].y & 0xffffu), y3 = o[3] * rs * g[3] * bf2f(gs[j].y >> 16);
            u32x2 w; w.x = cvt_pk_bf16(y0, y1); w.y = cvt_pk_bf16(y2, y3); *(u32x2*)(Y + off) = w; }
    }
}
__device__ __forceinline__ void diff_combine_phase(Frame& F, float lambda_init) {
    FRAME_OPAQUE(F);
    unsigned char* ws = F.ws; const float* lp = F.in[15]; const float* sub = F.in[16];
    const bf16_t* O0 = (const bf16_t*)(ws + SC_DO); const bf16_t* O1 = O0 + ACT_ELEMS; bf16_t* Y = (bf16_t*)(ws + WS_ACT);
    float d1 = lp[F.lane] * lp[128 + F.lane] + lp[64 + F.lane] * lp[128 + 64 + F.lane], d2 = lp[256 + F.lane] * lp[384 + F.lane] + lp[256 + 64 + F.lane] * lp[384 + 64 + F.lane];
    d1 = wave_sum(d1); d2 = wave_sum(d2);
    const float lam = expf(d1) - expf(d2) + lambda_init, osc = 1.f - lambda_init;
    const int gw = F.bx * NWAVES + F.wave, NGW = F.G * NWAVES;
    const f32x4 g = *(const f32x4*)(sub + 4 * F.lane);
    u32x2 a0n[8], a1n[8];
    if (gw < NBATCH * SEQ) { const int row = (gw >> 11) * TPB + CTXL + (gw & 2047);
#pragma unroll
        for (int j = 0; j < 8; ++j) { const size_t off = (size_t)row * DM + 4 * F.lane + 256 * j; a0n[j] = *(const u32x2*)(O0 + off); a1n[j] = *(const u32x2*)(O1 + off); } }
    for (int r = gw; r < NBATCH * SEQ; r += NGW) { const int row = (r >> 11) * TPB + CTXL + (r & 2047);
        u32x2 a0[8], a1[8];
#pragma unroll
        for (int j = 0; j < 8; ++j) { a0[j] = a0n[j]; a1[j] = a1n[j]; }
        { const int rn = r + NGW < NBATCH * SEQ ? r + NGW : r, rown = (rn >> 11) * TPB + CTXL + (rn & 2047);
#pragma unroll
            for (int j = 0; j < 8; ++j) { const size_t off = (size_t)rown * DM + 4 * F.lane + 256 * j; a0n[j] = *(const u32x2*)(O0 + off); a1n[j] = *(const u32x2*)(O1 + off); } }
#pragma unroll
        for (int j = 0; j < 8; ++j) { const size_t off = (size_t)row * DM + 4 * F.lane + 256 * j;
            const f32x4 o = (f32x4){bf2f(a0[j].x & 0xffffu), bf2f(a0[j].x >> 16), bf2f(a0[j].y & 0xffffu), bf2f(a0[j].y >> 16)} - (f32x4){bf2f(a1[j].x & 0xffffu), bf2f(a1[j].x >> 16), bf2f(a1[j].y & 0xffffu), bf2f(a1[j].y >> 16)} * lam;
            const float s = wave_sum((o[0] * o[0] + o[1] * o[1]) + (o[2] * o[2] + o[3] * o[3]));
            const float rs = rsqrtf(s * (1.f / 256.f) + NORM_EPS) * osc;
            u32x2 w; w.x = cvt_pk_bf16(o[0] * rs * g[0], o[1] * rs * g[1]); w.y = cvt_pk_bf16(o[2] * rs * g[2], o[3] * rs * g[3]); *(u32x2*)(Y + off) = w; }
    }
}

__global__ void __launch_bounds__(NTHR, 2) dit_fwd(Args args) {
    extern __shared__ __attribute__((aligned(16))) unsigned char lds_raw[];
    Frame F;
    F.lds = (LAS unsigned char*)lds_raw; F.ws = args.ws; F.in = args.in;
    F.tid = threadIdx.x; F.lane = F.tid & 63; F.wave = __builtin_amdgcn_readfirstlane(F.tid >> 6);
    F.G = gridDim.x; F.bx = blockIdx.x; F.vcu = (F.G % 8 == 0) ? (F.bx % 8) * (F.G / 8) + F.bx / 8 : F.bx;
    unsigned char* ws = args.ws;
    volatile LAS unsigned* MISC = (volatile LAS unsigned*)(F.lds + MISC_OFF);
    if (F.tid < 32) MISC[F.tid] = 0u;
    __syncthreads();
    XcdBarrier bar; bar.bar = (unsigned*)(ws + WS_CTL) + CW_BAR; bar.x = 0; bar.st = nullptr;
    if (!MK_PER_PHASE) bar = xcd_barrier_post((unsigned*)(ws + WS_CTL) + CW_BAR, MISC + 8);
    const int lo = args.ph_lo, hi = args.ph_hi;
    int pid = 0;
#ifndef PHMASK
#define PHMASK 0xFFFFF
#endif
#define EN(k) (((PHMASK) >> (k)) & 1)
#ifndef REPMASK
#define REPMASK 0
#endif
#define SITE(k) if (EN(k) && RUN) _Pragma("unroll 1") for (int rep_ = 0; rep_ < 1 + (((REPMASK) >> (k)) & 1); ++rep_, (rep_ < 1 + (((REPMASK) >> (k)) & 1)) ? xcd_barrier(bar) : (void)0)
#define RUN (lo <= pid && pid < hi)
#define SEAM do { if (!MK_PER_PHASE) { if (lo <= pid && pid + 1 < hi) xcd_barrier(bar); } ++pid; } while (0)
    using namespace pg8;
    const int G = F.G, c = F.bx;

    SITE(0) p0_prologue(F);
    SEAM;
    SITE(1) row_phase<0>(F, 0, false, true, nullptr, false);
    SEAM;

#pragma unroll 1
    for (int layer = 0; layer < DEPTH; ++layer) {
        const int mixer = layer % 3;
        const bool latonly = layer >= 2;
        const int nM = latonly ? 32 : 36;
        const bf16_t* WoT;
        if (mixer == 0) {
            const bool with_ctx = layer == 0;
            SITE(2) { SchedSeqDft S{(const char*)(ws + WS_CS), (const char*)(ws + SC_HT), (const char*)(ws + WS_CS256), (const char*)(ws + SC_HTC), with_ctx ? 1 : 0, G, c};
                EpiBf16<0> E{ws, SC_PQ, SC_PQC, 4096};
                gemm_phase<EpiBf16<0>, SchedSeqDft, true, true>(F.lds, 2048, 2048, S, E); }
            SEAM;
            SITE(3) { SchedChanDft S{(const char*)(ws + SC_PQ), (const char*)(ws + SC_PQC), (const char*)(ws + WS_CC), (const char*)(ws + WS_CC) + 512 * 512 * 2, with_ctx ? 1 : 0, G, c};
                EpiChan E{(bf16_t*)(ws + WS_ACT)};
                gemm_phase<EpiChan, SchedChanDft, true, true>(F.lds, 4096, 512, S, E); }
            SEAM;
            WoT = (const bf16_t*)(ws + WS_FWO) + (size_t)(layer / 3) * DM * DM;
        } else if (mixer == 1) {
            const bool defer_g = (G == 256);
            SITE(4) { SchedRows S{(const char*)(ws + WS_H), (const char*)(ws + WS_HWIN), 2048, 2048, 36, defer_g ? 35 : 40, 32, 0, G, c};
                EpiHgrn E{ws, (const float*)(ws + WS_LB)};
                gemm_phase<EpiHgrn, SchedRows, true, true>(F.lds, 2048, 2048, S, E); }
            SEAM;
            SITE(5) { if (defer_g && F.bx >= 128) { SchedRows S{(const char*)(ws + WS_H), (const char*)(ws + WS_HWIN) + (size_t)35 * 256 * 2048 * 2, 2048, 2048, 36, 5, 32, 0, 128, F.bx - 128, 35};
                    EpiHgrn E{ws, (const float*)(ws + WS_LB)};
                    gemm_phase<EpiHgrn, SchedRows, true, true>(F.lds, 2048, 2048, S, E); }
                for (int u = F.bx; u < 128; u += G) { const int b = u >> 5, h = (u >> 1) & 15, dir = u & 1;
                scan::scan_unit(F.lds, (const bf16_t*)(ws + SC_HQ), (const bf16_t*)(ws + SC_HK) + (size_t)dir * ACT_ELEMS, (const _Float16*)(ws + SC_HLF) + (size_t)dir * ACT_ELEMS,
                                (const bf16_t*)(ws + SC_HV), (bf16_t*)(ws + SC_HO) + (size_t)dir * ACT_ELEMS, b, h, dir); } }
            SEAM;
            SITE(6) hgrn_readout_phase(F);
            SEAM;
            WoT = (const bf16_t*)(ws + WS_HWO);
        } else {
            SITE(7) { SchedRows S{(const char*)(ws + WS_H), (const char*)(ws + WS_DQKV), 2048, 2048, 36, 24, 32, 0, G, c};
                EpiQkv E{ws, (const float*)(ws + WS_ROPE), (const float*)(ws + WS_ROPE) + 2048 * 64};
                gemm_phase<EpiQkv, SchedRows, true, true>(F.lds, 2048, 2048, S, E); }
            SEAM;
            SITE(8) {
                const float lambda_init = 0.8f - 0.6f * expf(-0.3f * (float)layer);
                const float* lp = F.in[15]; const float* sub = F.in[16];
                for (int u = F.vcu; u < 256; u += G) { const int qb = u & 7, h = (u >> 3) & 7, b = u >> 6;
                    const size_t qrow = (size_t)b * TPB + CTXL + qb * 256, krow = (size_t)b * TPB;
#pragma unroll 1
                    for (int mq = 0; mq < 4; ++mq) { const int m = mq >> 1, qh = mq & 1;
                        attn::attn_pair_body((const bf16_t*)(ws + SC_DQ) + (qrow + qh * 128) * DM + h * 256 + m * 128, (const bf16_t*)(ws + SC_DK) + krow * DM + h * 256 + m * 128,
                                             (const bf16_t*)(ws + SC_DV) + krow * DM + h * 256, (bf16_t*)(ws + SC_DO) + (size_t)m * ACT_ELEMS + (qrow + qh * 128) * DM + h * 256, TPB, (char*)lds_raw); }
                    VM_WAIT(); __syncthreads();
                    FRAME_OPAQUE(F);
                    float d1 = lp[F.lane] * lp[128 + F.lane] + lp[64 + F.lane] * lp[128 + 64 + F.lane], d2 = lp[256 + F.lane] * lp[384 + F.lane] + lp[256 + 64 + F.lane] * lp[384 + 64 + F.lane];
                    d1 = wave_sum(d1); d2 = wave_sum(d2);
                    const float lam = expf(d1) - expf(d2) + lambda_init, osc = 1.f - lambda_init;
                    const bf16_t* O0 = (const bf16_t*)(ws + SC_DO) + qrow * DM + h * 256; const bf16_t* O1 = O0 + ACT_ELEMS; bf16_t* Y = (bf16_t*)(ws + WS_ACT) + qrow * DM + h * 256;
                    const f32x4 g = *(const f32x4*)(sub + 4 * F.lane);
#pragma unroll 1
                    for (int r0 = F.wave; r0 < 256; r0 += 16 * NWAVES) {
                        u32x2 a0[16], a1[16];
#pragma unroll
                        for (int k = 0; k < 16; ++k) { const size_t off = (size_t)(r0 + k * NWAVES) * DM + 4 * F.lane; a0[k] = *(const u32x2*)(O0 + off); a1[k] = *(const u32x2*)(O1 + off); }
#pragma unroll
                        for (int k = 0; k < 16; ++k) { const size_t off = (size_t)(r0 + k * NWAVES) * DM + 4 * F.lane;
                            const f32x4 o = (f32x4){bf2f(a0[k].x & 0xffffu), bf2f(a0[k].x >> 16), bf2f(a0[k].y & 0xffffu), bf2f(a0[k].y >> 16)} - (f32x4){bf2f(a1[k].x & 0xffffu), bf2f(a1[k].x >> 16), bf2f(a1[k].y & 0xffffu), bf2f(a1[k].y >> 16)} * lam;
                            const float s = wave_sum((o[0] * o[0] + o[1] * o[1]) + (o[2] * o[2] + o[3] * o[3]));
                            const float rs = rsqrtf(s * (1.f / 256.f) + NORM_EPS) * osc;
                            u32x2 w; w.x = cvt_pk_bf16(o[0] * rs * g[0], o[1] * rs * g[1]); w.y = cvt_pk_bf16(o[2] * rs * g[2], o[3] * rs * g[3]); *(u32x2*)(Y + off) = w; } }
                    __syncthreads(); } }
            SEAM;
            WoT = (const bf16_t*)(ws + WS_DWO);
        }
        const bool splitk = !latonly && G == 256;
        SITE(10) { EpiF32 E{ws, WS_YO, WS_SLAB, SLAB_BYTES, 2048};
            if (splitk) { SchedRowsSK S{(const char*)(ws + WS_ACT), (const char*)WoT, 2048, 2048, 32, G, c}; gemm_phase<EpiF32, SchedRowsSK, true, true>(F.lds, 2048, 2048, S, E); }
            else { EpiF32 E2{ws, WS_YO, WS_YO, 0, 2048}; SchedRows S{(const char*)(ws + WS_ACT), (const char*)WoT, 2048, 2048, nM, 8, 32, latonly ? 1 : 0, G, c}; gemm_phase<EpiF32, SchedRows, true, true>(F.lds, 2048, 2048, S, E2); } }
        SEAM;
        SITE(11) row_phase<1>(F, layer, latonly, false, nullptr, splitk);
        SEAM;
        SITE(12) { SchedRows S{(const char*)(ws + WS_H), (const char*)(ws + WS_W1T) + (size_t)layer * DM * HID * 2, 2048, 2048, nM, 32, 32, latonly ? 1 : 0, G, c};
            EpiBf16<1> E{ws, SC_U, SC_U, HID};
            gemm_phase<EpiBf16<1>, SchedRows, true, true>(F.lds, 2048, 2048, S, E); }
        SEAM;
        SITE(13) { EpiF32 E{ws, WS_YO, WS_SLAB, SLAB_BYTES, 2048}; const char* W2 = (const char*)(ws + WS_W2T) + (size_t)layer * DM * HID * 2;
            if (splitk) { SchedRowsSK S{(const char*)(ws + SC_U), W2, HID, HID, 128, G, c}; gemm_phase<EpiF32, SchedRowsSK, true, true>(F.lds, HID, HID, S, E); }
            else { EpiF32 E2{ws, WS_YO, WS_YO, 0, 2048}; SchedRows S{(const char*)(ws + SC_U), W2, HID, HID, nM, 8, 128, latonly ? 1 : 0, G, c}; gemm_phase<EpiF32, SchedRows, true, true>(F.lds, HID, HID, S, E2); } }
        SEAM;
        SITE(14) row_phase<2>(F, layer, layer >= 2, layer == 2, layer == 3 ? args.out : nullptr, splitk);
        SEAM;
    }
#undef RUN
#undef SEAM
}

constexpr int N_PHASES = 2 + 7 + 8 + 7 + 7;
extern "C" void kernel_launch(void* const* d_in, const int* in_sizes, int n_in, void* d_out, int out_size, void* d_ws, size_t ws_size, hipStream_t stream) {
    static int grid = 0;
    if (grid == 0) {
        if (n_in != 18 || out_size != NBATCH * SEQ * DM || ws_size < WS_END) { fprintf(stderr, "kernel_launch: unexpected shapes (n_in %d out %d ws %zu)\n", n_in, out_size, ws_size); grid = -1; return; }
        int dev = 0, cus = 0, per_cu = 0;
        if (hipGetDevice(&dev) != hipSuccess || hipDeviceGetAttribute(&cus, hipDeviceAttributeMultiprocessorCount, dev) != hipSuccess) { grid = -1; return; }
        if (hipFuncSetAttribute((const void*)dit_fwd, hipFuncAttributeMaxDynamicSharedMemorySize, LDS_BYTES) != hipSuccess) { fprintf(stderr, "kernel_launch: hipFuncSetAttribute failed\n"); grid = -1; return; }
        if (hipOccupancyMaxActiveBlocksPerMultiprocessor(&per_cu, (const void*)dit_fwd, NTHR, LDS_BYTES) != hipSuccess || per_cu < 1) fprintf(stderr, "kernel_launch: occupancy query says %d\n", per_cu);
        (void)hipGetLastError();
        grid = cus;
    }
    if (grid < 0) return;
    (void)hipMemsetAsync((char*)d_ws + WS_CTL, 0, CTL_BYTES, stream);
    Args a{};
    for (int i = 0; i < 18; ++i) a.in[i] = (const float*)d_in[i];
    a.out = (float*)d_out; a.ws = (unsigned char*)d_ws;
#if MK_PER_PHASE
    for (int p = 0; p < N_PHASES; ++p) { a.ph_lo = p; a.ph_hi = p + 1; hipLaunchKernelGGL(dit_fwd, dim3(grid), dim3(NTHR), LDS_BYTES, stream, a); }
#else
    a.ph_lo = 0; a.ph_hi = N_PHASES; hipLaunchKernelGGL(dit_fwd, dim3(grid), dim3(NTHR), LDS_BYTES, stream, a);
#endif
    const hipError_t le = hipPeekAtLastError();
    if (le != hipSuccess) fprintf(stderr, "kernel_launch: launch failed: %s\n", hipGetErrorName(le));
}
```

```cpp
#include <hip/hip_runtime.h>
#include <cstdio>
#include <cstdint>

#ifndef MK_PER_PHASE
#define MK_PER_PHASE 0
#endif

#define LAS __attribute__((address_space(3)))
#define GAS __attribute__((address_space(1)))
typedef unsigned short bf16_t;
typedef short bf16x8 __attribute__((ext_vector_type(8)));
typedef short s16x4 __attribute__((ext_vector_type(4)));
typedef float f32x4 __attribute__((ext_vector_type(4)));
typedef float f32x2 __attribute__((ext_vector_type(2)));
typedef float f32x8 __attribute__((ext_vector_type(8)));
typedef float f32x16 __attribute__((ext_vector_type(16)));
typedef unsigned u32x4 __attribute__((ext_vector_type(4)));
typedef unsigned u32x2 __attribute__((ext_vector_type(2)));

constexpr int DM = 2048, NBATCH = 4, SEQ = 2048, CTXL = 256, TPB = SEQ + CTXL, NROW = NBATCH * TPB, DEPTH = 4, HID = 8192;
constexpr float NORM_EPS = 1e-6f;
constexpr int NWAVES = 8, NTHR = 512;

constexpr size_t MiB = 1u << 20;
constexpr size_t WS_CTL = 0, CTL_BYTES = 1 * MiB;
constexpr size_t WS_MOD = 1 * MiB;
constexpr size_t WS_LB = 2 * MiB;
constexpr size_t WS_ROPE = 2 * MiB + 64 * 1024;
constexpr size_t WS_CS = 4 * MiB;
constexpr size_t WS_CS256 = 20 * MiB;
constexpr size_t WS_CC = 22 * MiB;
constexpr size_t WS_W1T = 32 * MiB;
constexpr size_t WS_W2T = 160 * MiB;
constexpr size_t WS_FWO = 288 * MiB;
constexpr size_t WS_HWIN = 304 * MiB;
constexpr size_t WS_HWO = 344 * MiB;
constexpr size_t WS_DQKV = 352 * MiB;
constexpr size_t WS_DWO = 376 * MiB;
constexpr size_t WS_X = 384 * MiB;
constexpr size_t WS_H = 456 * MiB;
constexpr size_t WS_ACT = 492 * MiB;
constexpr size_t WS_YO = 528 * MiB;
constexpr size_t WS_SCR = 600 * MiB;
constexpr size_t WS_SLAB = 1112 * MiB;
constexpr size_t SLAB_BYTES = (size_t)NBATCH * CTXL * DM * 2;
constexpr size_t WS_END = 1176 * MiB;
constexpr size_t SC_U = WS_SCR;
constexpr size_t SC_HT = WS_SCR, SC_HTC = WS_SCR + 32 * MiB, SC_PQ = WS_SCR + 64 * MiB, SC_PQC = WS_SCR + 128 * MiB;
constexpr size_t SC_HQ = WS_SCR, SC_HV = WS_SCR + 36 * MiB, SC_HG = WS_SCR + 72 * MiB, SC_HK = WS_SCR + 108 * MiB, SC_HLF = WS_SCR + 180 * MiB, SC_HO = WS_SCR + 324 * MiB;
constexpr size_t SC_DQ = WS_SCR, SC_DK = WS_SCR + 36 * MiB, SC_DV = WS_SCR + 72 * MiB, SC_DO = WS_SCR + 108 * MiB;
constexpr size_t ACT_ELEMS = (size_t)NROW * DM;

constexpr int CW_BAR = 4096;
constexpr int LDS_BYTES = 147456;
constexpr int MISC_OFF = 131072 + 8192;

typedef __bf16 bf16x2_t __attribute__((ext_vector_type(2)));
__device__ __forceinline__ unsigned cvt_pk_bf16(float lo, float hi) { const f32x2 v = {lo, hi}; const bf16x2_t b = __builtin_convertvector(v, bf16x2_t); return __builtin_bit_cast(unsigned, b); }
__device__ __forceinline__ unsigned f2bf(float f) { unsigned u = __builtin_bit_cast(unsigned, f); return (u + 0x7fffu + ((u >> 16) & 1u)) >> 16; }
__device__ __forceinline__ float bf2f(unsigned b) { return __builtin_bit_cast(float, b << 16); }
__device__ __forceinline__ float wave_sum(float v) {
#pragma unroll
    for (int o = 1; o < 64; o <<= 1) v += __shfl_xor(v, o);
    return v;
}
#define LDS_WAIT() asm volatile("s_waitcnt lgkmcnt(0)" ::: "memory")
#define VM_WAIT() asm volatile("s_waitcnt vmcnt(0)" ::: "memory")

#define XB_TMO      128
#define XB_XCNT(j)  (256  + 64 * (j))
#define XB_XSUB(j)  (1280 + 64 * (j))
#define XB_XGEN(j)  (2304 + 64 * (j))
#define XB_TOP      3328
#define XB_TOPGEN   3392
#define XCD_BAR_WORDS 3456
#define XB_SPIN_CAP (1u << 20)
__device__ __forceinline__ unsigned xb_ld(unsigned* p)              { return __hip_atomic_load(p, __ATOMIC_RELAXED, __HIP_MEMORY_SCOPE_AGENT); }
__device__ __forceinline__ unsigned xb_add(unsigned* p, unsigned v) { return __hip_atomic_fetch_add(p, v, __ATOMIC_RELAXED, __HIP_MEMORY_SCOPE_AGENT); }
__device__ __forceinline__ unsigned xb_xcc_id() { return (unsigned)__builtin_amdgcn_s_getreg((3 << 11) | 20) & 0xFu; }
#define XB_SPIN(cond, bar) do { unsigned _sp = 0; while (cond) { __builtin_amdgcn_s_sleep(1); \
    if ((++_sp & 255u) == 0u) { if (xb_ld(&(bar)[XB_TMO])) break; if (_sp > XB_SPIN_CAP) { atomicAdd(&(bar)[XB_TMO], 1u); break; } } } } while (0)
struct XcdBarrier { unsigned* bar; unsigned x; volatile LAS unsigned* st; };
__device__ __forceinline__ XcdBarrier xcd_barrier_post(unsigned* bar, volatile LAS unsigned* st) {
    XcdBarrier b; b.bar = bar; b.x = xb_xcc_id(); b.st = st;
    if (threadIdx.x == 0) (void)xb_add(&bar[XB_XCNT(b.x)], 1u);
    return b;
}
__device__ __forceinline__ void xcd_barrier_complete(unsigned* bar, unsigned x, unsigned& nloc, unsigned& nx) {
    const unsigned G = gridDim.x * gridDim.y * gridDim.z;
    unsigned sum, cnt, mine, sp = 0u;
    for (;;) {
        sum = 0u; cnt = 0u; mine = 0u;
#pragma unroll
        for (unsigned j = 0; j < 16; ++j) { const unsigned c = xb_ld(&bar[XB_XCNT(j)]); sum += c; cnt += (c > 0u) ? 1u : 0u; mine = (j == x) ? c : mine; }
        if (sum == G) break;
        __builtin_amdgcn_s_sleep(1);
        if ((++sp & 255u) == 0u) { if (xb_ld(&bar[XB_TMO])) break; if (sp > XB_SPIN_CAP) { atomicAdd(&bar[XB_TMO], 1u); break; } }
    }
    nloc = mine > 0u ? mine : 1u; nx = cnt > 0u ? cnt : 1u;
}
__device__ __forceinline__ void xcd_barrier(const XcdBarrier& b) {
    asm volatile("s_waitcnt vmcnt(0)" ::: "memory");
    __syncthreads();
    if (threadIdx.x == 0) {
        unsigned* bar = b.bar;
        __builtin_amdgcn_s_waitcnt(0);
        unsigned nloc = b.st[0], nx = b.st[1];
        if (nloc == 0u) { xcd_barrier_complete(bar, b.x, nloc, nx); b.st[0] = nloc; b.st[1] = nx; }
        const unsigned old = xb_add(&bar[XB_XSUB(b.x)], 1u);
        const unsigned gen = old / nloc;
        if (old + 1u == (gen + 1u) * nloc) {
            __builtin_amdgcn_fence(__ATOMIC_RELEASE, "agent");
            asm volatile("s_waitcnt vmcnt(0)" ::: "memory");
            const unsigned og = xb_add(&bar[XB_TOP], 1u);
            const unsigned tg = og / nx;
            if (og + 1u == (tg + 1u) * nx) xb_add(&bar[XB_TOPGEN], 1u);
            else XB_SPIN(xb_ld(&bar[XB_TOPGEN]) == tg, bar);
            __builtin_amdgcn_fence(__ATOMIC_ACQUIRE, "agent");
            xb_add(&bar[XB_XGEN(b.x)], 1u);
            asm volatile("s_waitcnt vmcnt(0)" ::: "memory");
        } else {
            XB_SPIN(xb_ld(&bar[XB_TOPGEN]) == gen, bar);
            __builtin_amdgcn_fence(__ATOMIC_ACQUIRE, "agent");
            asm volatile("s_waitcnt vmcnt(0)" ::: "memory");
        }
    }
    __syncthreads();
}

namespace pg8 {
constexpr int BM = 256, BK = 64, HALF = 128, HTB = HALF * BK * 2, STAGE_BYTES = 8 * HTB;
__device__ __forceinline__ int lds_byte(int r, int c) { const int st = (r >> 4) * 2 + (c >> 5), rr = r & 15, cc = c & 31, ob = rr * 64 + cc * 2; return st * 1024 + (ob ^ (((ob >> 9) & 1) << 5)); }
__device__ __forceinline__ void stage_rc(int b, int& R, int& C) { const int st = b / 1024, sb = b % 1024, swz = sb ^ (((sb >> 9) & 1) << 5); R = (st >> 1) * 16 + swz / 64; C = (st & 1) * 32 + (swz % 64) / 2; }
__device__ __forceinline__ int perm32(int rho) { const int n = rho >> 4, i = rho & 15; return 8 * (i >> 2) + 4 * n + (i & 3); }

struct GUnit { const char* A; const char* B; int nt; int orow, ocol, aux; };

__device__ __forceinline__ void tile_swz(int L, int nM, int nN, int& pm, int& pn) {
    const int nwg = nM * nN; int wgid = L;
    { const int q = nwg / 8, r = nwg % 8, xcd = wgid % 8, off = wgid / 8; wgid = (xcd < r ? xcd * (q + 1) : r * (q + 1) + (xcd - r) * q) + off; }
    const int nig = 8 * nN, gid = wgid / nig, fm = gid * 8, gsz = (nM - fm) < 8 ? (nM - fm) : 8;
    pm = fm + ((wgid % nig) % gsz); pn = (wgid % nig) / gsz;
}

template <class Epi, class Sched, bool ALIGN_EPI, bool SP2>
__device__ __forceinline__ void gemm_phase(LAS unsigned char* lds, const int lda, const int ldb, const Sched& S, const Epi& E) {
    int tid_ = threadIdx.x; asm volatile("" : "+v"(tid_));
    const int tid = tid_, wid = __builtin_amdgcn_readfirstlane(tid >> 6), lane = tid & 63, wr = wid >> 2, wc = wid & 3, fr = lane & 15, fq = lane >> 4;
    unsigned voffA[2], voffB[2];
#pragma unroll
    for (int i = 0; i < 2; ++i) { int R, C; stage_rc(tid * 16 + i * 8192, R, C); const int Rb = (R & ~31) + perm32(R & 31);
        voffA[i] = (unsigned)(R * lda + C) * 2u; voffB[i] = (unsigned)(Rb * ldb + C) * 2u; }
    const size_t kstep = (size_t)(BK * 2);
    const size_t hstepA = (size_t)HALF * lda * 2, hstepB = (size_t)HALF * ldb * 2;
    const unsigned ldsw = (unsigned)wid * 1024u;
    const int aoff = lds_byte(wr * 64 + fr, fq * 8), boff = lds_byte(wc * 32 + fr, fq * 8);
#define PG8_SA(b, h) (((b) * 2 + (h)) * HTB)
#define PG8_SB(b, h) ((4 + (b) * 2 + (h)) * HTB)
#define PG8_STAGE(bufoff, gbase, voff) do { _Pragma("unroll") for (int _i = 0; _i < 2; ++_i) \
        __builtin_amdgcn_global_load_lds((const unsigned*)((const char*)(gbase) + (voff)[_i]), (LAS unsigned*)(lds + (bufoff) + ldsw + _i * 8192), 16, 0, 0); } while (0)
#define PG8_LDA(dst, b, h) do { _Pragma("unroll") for (int m = 0; m < 4; ++m) _Pragma("unroll") for (int k = 0; k < 2; ++k) dst[m][k] = *(const LAS bf16x8*)(lds + PG8_SA(b, h) + aoff + m * 2048 + k * 1024); } while (0)
#define PG8_LDB(dst, b, h) do { _Pragma("unroll") for (int n = 0; n < 2; ++n) _Pragma("unroll") for (int k = 0; k < 2; ++k) dst[n][k] = *(const LAS bf16x8*)(lds + PG8_SB(b, h) + boff + n * 2048 + k * 1024); } while (0)
#define PG8_MMA(ai, bj, At, Bt) do { __builtin_amdgcn_s_setprio(1); _Pragma("unroll") for (int m = 0; m < 4; ++m) _Pragma("unroll") for (int n = 0; n < 2; ++n) _Pragma("unroll") for (int k = 0; k < 2; ++k) \
        acc[ai][bj][m][n] = __builtin_amdgcn_mfma_f32_16x16x32_bf16(Bt[n][k], At[m][k], acc[ai][bj][m][n], 0, 0, 0); __builtin_amdgcn_s_setprio(0); } while (0)
#define PG8_WAIT_V(n) asm volatile("s_waitcnt vmcnt(" #n ")" ::: "memory")
#define PG8_WAIT_L(n) asm volatile("s_waitcnt lgkmcnt(" #n ")" ::: "memory")
#define PG8_BAR __builtin_amdgcn_s_barrier()
#define PG8_SCHED __builtin_amdgcn_sched_barrier(0)
    GUnit cur, nxt; int ui = 0;
    if (!S.next(0, cur)) return;
    f32x4 acc[2][2][4][2];
#pragma unroll
    for (int a = 0; a < 2; ++a)
#pragma unroll
        for (int b = 0; b < 2; ++b)
#pragma unroll
            for (int m = 0; m < 4; ++m)
#pragma unroll
                for (int n = 0; n < 2; ++n) acc[a][b][m][n] = (f32x4){0.f, 0.f, 0.f, 0.f};
    bf16x8 At[4][2], B0[2][2], B1[2][2];
    const char* cA = cur.A; const char* cB = cur.B;
    if constexpr (SP2) {
        PG8_STAGE(PG8_SB(0, 0), cB, voffB); PG8_STAGE(PG8_SB(0, 1), cB + hstepB, voffB); PG8_STAGE(PG8_SA(0, 0), cA, voffA); PG8_STAGE(PG8_SA(0, 1), cA + hstepA, voffA);
        if (wr == 1) PG8_BAR;
        PG8_WAIT_V(2); PG8_BAR;
        PG8_STAGE(PG8_SB(1, 0), cB + kstep, voffB); PG8_STAGE(PG8_SA(1, 0), cA + kstep, voffA); PG8_STAGE(PG8_SB(1, 1), cB + hstepB + kstep, voffB);
        PG8_WAIT_V(6); PG8_BAR;
    } else {
        PG8_STAGE(PG8_SB(0, 0), cB, voffB); PG8_STAGE(PG8_SA(0, 0), cA, voffA); PG8_STAGE(PG8_SB(0, 1), cB + hstepB, voffB); PG8_STAGE(PG8_SA(0, 1), cA + hstepA, voffA);
        if (wr == 1) PG8_BAR;
        PG8_WAIT_V(4); PG8_BAR;
        PG8_STAGE(PG8_SB(1, 0), cB + kstep, voffB); PG8_STAGE(PG8_SA(1, 0), cA + kstep, voffA); PG8_STAGE(PG8_SB(1, 1), cB + hstepB + kstep, voffB);
        PG8_WAIT_V(6); PG8_BAR;
    }
    for (;;) {
        const bool has_next = S.next(ui + 1, nxt);
        const char* nA = has_next ? nxt.A : cA; const char* nB = has_next ? nxt.B : cB;
        const int nt = cur.nt;
        for (int t = 0; t < nt; t += 2) {
            const bool last = (t == nt - 2);
            const char* a1 = cA + (size_t)(t + 1) * kstep;
            const char* a2 = last ? nA : cA + (size_t)(t + 2) * kstep; const char* b2 = last ? nB : cB + (size_t)(t + 2) * kstep;
            const char* a3 = a2 + kstep; const char* b3 = b2 + kstep;
            if constexpr (SP2) {
            PG8_LDB(B0, 0, 0); PG8_LDB(B1, 0, 1); PG8_SCHED; PG8_LDA(At, 0, 0); PG8_STAGE(PG8_SA(1, 1), a1 + hstepA, voffA);
            PG8_WAIT_V(8); PG8_WAIT_L(0); PG8_BAR; PG8_MMA(0, 0, At, B0); PG8_MMA(0, 1, At, B1); PG8_BAR; PG8_SCHED;
            PG8_LDA(At, 0, 1); PG8_STAGE(PG8_SB(0, 0), b2, voffB); PG8_STAGE(PG8_SB(0, 1), b2 + hstepB, voffB); PG8_STAGE(PG8_SA(0, 0), a2, voffA);
            PG8_WAIT_V(8); PG8_WAIT_L(0); PG8_BAR; PG8_MMA(1, 0, At, B0); PG8_MMA(1, 1, At, B1); PG8_BAR; PG8_SCHED;
            PG8_LDB(B0, 1, 0); PG8_LDB(B1, 1, 1); PG8_SCHED; PG8_LDA(At, 1, 0); PG8_STAGE(PG8_SA(0, 1), a2 + hstepA, voffA);
            PG8_WAIT_V(8); PG8_WAIT_L(0); PG8_BAR; PG8_MMA(0, 0, At, B0); PG8_MMA(0, 1, At, B1); PG8_BAR; PG8_SCHED;
            PG8_LDA(At, 1, 1); PG8_STAGE(PG8_SB(1, 0), b3, voffB); PG8_STAGE(PG8_SB(1, 1), b3 + hstepB, voffB); PG8_STAGE(PG8_SA(1, 0), a3, voffA);
            PG8_WAIT_V(8); PG8_WAIT_L(0); PG8_BAR; PG8_MMA(1, 0, At, B0); PG8_MMA(1, 1, At, B1); PG8_BAR; PG8_SCHED;
            } else {
            PG8_LDB(B0, 0, 0); PG8_SCHED; PG8_LDA(At, 0, 0); PG8_STAGE(PG8_SA(1, 1), a1 + hstepA, voffA);
            PG8_WAIT_L(8); PG8_BAR; PG8_WAIT_L(0); PG8_MMA(0, 0, At, B0); PG8_BAR; PG8_SCHED;
            PG8_LDB(B1, 0, 1); PG8_STAGE(PG8_SB(0, 0), b2, voffB);
            PG8_BAR; PG8_WAIT_L(0); PG8_MMA(0, 1, At, B1); PG8_BAR;
            PG8_LDA(At, 0, 1); PG8_STAGE(PG8_SA(0, 0), a2, voffA);
            PG8_BAR; PG8_WAIT_L(0); PG8_MMA(1, 0, At, B0); PG8_BAR; PG8_SCHED;
            PG8_STAGE(PG8_SB(0, 1), b2 + hstepB, voffB);
            PG8_WAIT_V(6); PG8_BAR; PG8_MMA(1, 1, At, B1); PG8_BAR;
            PG8_LDB(B0, 1, 0); PG8_SCHED; PG8_LDA(At, 1, 0); PG8_STAGE(PG8_SA(0, 1), a2 + hstepA, voffA);
            PG8_WAIT_L(8); PG8_BAR; PG8_WAIT_L(0); PG8_MMA(0, 0, At, B0); PG8_BAR; PG8_SCHED;
            PG8_LDB(B1, 1, 1); PG8_STAGE(PG8_SB(1, 0), b3, voffB);
            PG8_BAR; PG8_WAIT_L(0); PG8_MMA(0, 1, At, B1); PG8_BAR;
            PG8_LDA(At, 1, 1); PG8_STAGE(PG8_SA(1, 0), a3, voffA);
            PG8_BAR; PG8_WAIT_L(0); PG8_MMA(1, 0, At, B0); PG8_BAR; PG8_SCHED;
            PG8_STAGE(PG8_SB(1, 1), b3 + hstepB, voffB);
            PG8_WAIT_V(6); PG8_BAR; PG8_MMA(1, 1, At, B1); PG8_BAR;
            }
        }
        if constexpr (ALIGN_EPI) { if (wr == 0) PG8_BAR; }
        E(acc, cur, wr, wc, fr, fq);
        if (!has_next) break;
#pragma unroll
        for (int a = 0; a < 2; ++a)
#pragma unroll
            for (int b = 0; b < 2; ++b)
#pragma unroll
                for (int m = 0; m < 4; ++m)
#pragma unroll
                    for (int n = 0; n < 2; ++n) acc[a][b][m][n] = (f32x4){0.f, 0.f, 0.f, 0.f};
        cur = nxt; cA = nA; cB = nB; ++ui;
        if constexpr (ALIGN_EPI) { if (wr == 1) PG8_BAR; }
    }
    PG8_WAIT_V(0);
    if constexpr (!ALIGN_EPI) { if (wr == 0) PG8_BAR; }
    PG8_BAR;
#undef PG8_SA
#undef PG8_SB
#undef PG8_STAGE
#undef PG8_LDA
#undef PG8_LDB
#undef PG8_MMA
#undef PG8_WAIT_V
#undef PG8_WAIT_L
#undef PG8_BAR
#undef PG8_SCHED
}

__device__ __forceinline__ int panel_row(int pm, int latonly) { return latonly ? ((pm >> 3) * TPB + CTXL + (pm & 7) * 256) : pm * 256; }
struct SchedRows {
    const char* A; const char* B; int lda, ldb, nM, nN, nt, latonly, G, c; int auxoff = 0;
    __device__ __forceinline__ bool next(int i, GUnit& u) const {
        const int L = i * G + c; if (L >= nM * nN) return false;
        int pm, pn; tile_swz(L, nM, nN, pm, pn); const int row = panel_row(pm, latonly);
        u.A = A + (size_t)row * lda * 2; u.B = B + (size_t)pn * 256 * ldb * 2; u.nt = nt; u.orow = row; u.ocol = pn * 256; u.aux = pn + auxoff; return true;
    }
};
struct SchedRowsSK {
    const char* A; const char* B; int lda, ldb, ntfull, G, c;
    __device__ __forceinline__ bool next(int i, GUnit& u) const {
        if (i == 0) { int pm, pn; tile_swz(c, 32, 8, pm, pn); const int row = panel_row(pm, 1);
            u.A = A + (size_t)row * lda * 2; u.B = B + (size_t)pn * 256 * ldb * 2; u.nt = ntfull; u.orow = row; u.ocol = pn * 256; u.aux = 0; return true; }
        if (i == 1) { const int id = c >> 3, ks = c & 7, b = id >> 3, pn = id & 7, kof = ks * (ntfull / 8) * 64;
            u.A = A + ((size_t)(b * TPB) * lda + kof) * 2; u.B = B + ((size_t)pn * 256 * ldb + kof) * 2; u.nt = ntfull / 8; u.orow = b * CTXL; u.ocol = pn * 256; u.aux = 1 + ks; return true; }
        return false;
    }
};
struct SchedSeqDft {
    const char* CS; const char* HT; const char* CS256; const char* HTC; int with_ctx, G, c;
    __device__ __forceinline__ bool next(int i, GUnit& u) const {
        const int L = i * G + c;
        if (L < 256) { int pm, pn; tile_swz(L, 32, 8, pm, pn); const int b = pm >> 3, p = pm & 7;
            u.A = CS + (size_t)p * 256 * 2048 * 2; u.B = HT + ((size_t)b * 2048 + pn * 256) * 2048 * 2; u.nt = 32; u.orow = b * 1024 + (p & 3) * 256; u.ocol = pn * 512 + (p >> 2) * 256; u.aux = 0; return true; }
        if (with_ctx && L < 320) { const int e = L - 256, b = e >> 4, p = (e >> 3) & 1, pn = e & 7;
            u.A = CS256 + (size_t)p * 256 * 2048 * 2; u.B = HTC + ((size_t)b * 2048 + pn * 256) * 2048 * 2; u.nt = 4; u.orow = b * 256; u.ocol = pn * 512 + p * 256; u.aux = 1; return true; }
        return false;
    }
};
struct SchedChanDft {
    const char* PQ; const char* PQC; const char* CC2; const char* CC3; int with_ctx, G, c;
    __device__ __forceinline__ bool next(int i, GUnit& u) const {
        const int L = i * G + c;
        if (L < 256) { int pm, pn; tile_swz(L, 16, 16, pm, pn); const int b = pm >> 2, lt = pm & 3, g = pn >> 1, sgn = pn & 1;
            u.A = PQ + (((size_t)b * 1024 + lt * 256) * 4096 + g * 512) * 2; u.B = CC2 + (size_t)sgn * 256 * 512 * 2; u.nt = 8; u.ocol = g * 256;
            u.orow = b * TPB + CTXL + (sgn ? SEQ - lt * 256 : lt * 256); u.aux = (lt == 0 ? 1 : 0) | (sgn ? 2 : 0); return true; }
        if (L < 320) { const int e = L - 256, b = e >> 4, g = (e >> 1) & 7, half = e & 1;
            u.A = PQ + (((size_t)b * 1024) * 4096 + g * 512) * 2; u.B = CC3 + (size_t)half * 256 * 512 * 2; u.nt = 8; u.ocol = g * 256; u.orow = b * TPB + CTXL + half * 1024; u.aux = 4; return true; }
        if (with_ctx && L < 352) { const int e = L - 320, b = e >> 3, g = e & 7;
            u.A = PQC + ((size_t)b * 256 * 4096 + g * 512) * 2; u.B = CC2; u.nt = 8; u.orow = b * TPB; u.ocol = g * 256; u.aux = 0; return true; }
        return false;
    }
};

template <int ACT  > struct EpiBf16 {
    unsigned char* ws; size_t off0, off1; int ldc;
    __device__ __forceinline__ void operator()(f32x4 (&acc)[2][2][4][2], const GUnit& u, int wr, int wc, int fr, int fq) const {
        bf16_t* base = (bf16_t*)(ws + (u.aux ? off1 : off0));
        const int row0 = u.orow + wr * 64 + fr, col0 = u.ocol + wc * 32 + 8 * fq;
#pragma unroll
        for (int ai = 0; ai < 2; ++ai)
#pragma unroll
            for (int m = 0; m < 4; ++m) { bf16_t* rowp = base + (size_t)(row0 + ai * HALF + m * 16) * ldc + col0;
#pragma unroll
                for (int bj = 0; bj < 2; ++bj) { f32x4 v0 = acc[ai][bj][m][0], v1 = acc[ai][bj][m][1];
                    if (ACT == 1) {
#pragma unroll
                        for (int j = 0; j < 4; ++j) { const float a = fmaxf(v0[j], 0.f), b = fmaxf(v1[j], 0.f); v0[j] = a * a; v1[j] = b * b; } }
                    u32x4 w; w.x = cvt_pk_bf16(v0[0], v0[1]); w.y = cvt_pk_bf16(v0[2], v0[3]); w.z = cvt_pk_bf16(v1[0], v1[1]); w.w = cvt_pk_bf16(v1[2], v1[3]);
                    *(u32x4*)(rowp + bj * HALF) = w; } }
    }
};
struct EpiChan {
    bf16_t* O;
    __device__ __forceinline__ void operator()(f32x4 (&acc)[2][2][4][2], const GUnit& u, int wr, int wc, int fr, int fq) const {
        const int col0 = u.ocol + wc * 32 + 8 * fq;
#pragma unroll
        for (int ai = 0; ai < 2; ++ai)
#pragma unroll
            for (int m = 0; m < 4; ++m) { const int r = ai * HALF + wr * 64 + m * 16 + fr;
                const bool on = (u.aux & 4) ? (r == 0) : !((u.aux & 1) && r == 0);
                const int drow = (u.aux & 4) ? u.orow : ((u.aux & 2) ? u.orow - r : u.orow + r);
                bf16_t* rowp = O + (size_t)drow * 2048 + col0;
                if (on) {
#pragma unroll
                    for (int bj = 0; bj < 2; ++bj) { const f32x4 v0 = acc[ai][bj][m][0], v1 = acc[ai][bj][m][1];
                        u32x4 w; w.x = cvt_pk_bf16(v0[0], v0[1]); w.y = cvt_pk_bf16(v0[2], v0[3]); w.z = cvt_pk_bf16(v1[0], v1[1]); w.w = cvt_pk_bf16(v1[2], v1[3]);
                        *(u32x4*)(rowp + bj * HALF) = w; } } }
    }
};
struct EpiF32 {
    unsigned char* ws; size_t off0, off1, slab; int ldc;
    __device__ __forceinline__ void operator()(f32x4 (&acc)[2][2][4][2], const GUnit& u, int wr, int wc, int fr, int fq) const {
        const int row0 = u.orow + wr * 64 + fr, col0 = u.ocol + wc * 32 + 8 * fq;
        if (u.aux && slab) {
            bf16_t* C = (bf16_t*)(ws + off1 + (size_t)(u.aux - 1) * slab);
#pragma unroll
            for (int ai = 0; ai < 2; ++ai)
#pragma unroll
                for (int m = 0; m < 4; ++m) { bf16_t* rowp = C + (size_t)(row0 + ai * HALF + m * 16) * ldc + col0;
#pragma unroll
                    for (int bj = 0; bj < 2; ++bj) { const f32x4 v0 = acc[ai][bj][m][0], v1 = acc[ai][bj][m][1];
                        u32x4 w; w.x = cvt_pk_bf16(v0[0], v0[1]); w.y = cvt_pk_bf16(v0[2], v0[3]); w.z = cvt_pk_bf16(v1[0], v1[1]); w.w = cvt_pk_bf16(v1[2], v1[3]);
                        *(u32x4*)(rowp + bj * HALF) = w; } }
        } else {
            bf16_t* C = (bf16_t*)(ws + off0);
#pragma unroll
            for (int ai = 0; ai < 2; ++ai)
#pragma unroll
                for (int m = 0; m < 4; ++m) { bf16_t* rowp = C + (size_t)(row0 + ai * HALF + m * 16) * ldc + col0;
#pragma unroll
                    for (int bj = 0; bj < 2; ++bj) { const f32x4 v0 = acc[ai][bj][m][0], v1 = acc[ai][bj][m][1];
                        u32x4 w; w.x = cvt_pk_bf16(v0[0], v0[1]); w.y = cvt_pk_bf16(v0[2], v0[3]); w.z = cvt_pk_bf16(v1[0], v1[1]); w.w = cvt_pk_bf16(v1[2], v1[3]);
                        *(u32x4*)(rowp + bj * HALF) = w; } }
        }
    }
};
__device__ __forceinline__ float fast_sigmoid(float z) { return __builtin_amdgcn_rcpf(1.f + __builtin_amdgcn_exp2f(-1.4426950408889634f * z)); }
struct EpiHgrn {
    unsigned char* ws; const float* lb;
    __device__ __forceinline__ void operator()(f32x4 (&acc)[2][2][4][2], const GUnit& u, int wr, int wc, int fr, int fq) const {
        const int ty = u.aux >> 3, ocol = (u.aux & 7) * 256;
        const int row0 = u.orow + wr * 64 + fr, col0 = ocol + wc * 32 + 8 * fq;
        if (ty == 1 || ty == 2) {
            const int dir = ty - 1; _Float16* lf = (_Float16*)(ws + SC_HLF) + (size_t)dir * ACT_ELEMS; bf16_t* kk = (bf16_t*)(ws + SC_HK) + (size_t)dir * ACT_ELEMS;
#pragma unroll
            for (int bj = 0; bj < 2; ++bj) {
                const f32x4 l0 = *(const f32x4*)(lb + dir * 2048 + col0 + bj * HALF), l1 = *(const f32x4*)(lb + dir * 2048 + col0 + bj * HALF + 4);
#pragma unroll
                for (int ai = 0; ai < 2; ++ai)
#pragma unroll
                    for (int m = 0; m < 4; ++m) { const size_t off = (size_t)(row0 + ai * HALF + m * 16) * 2048 + col0 + bj * HALF;
                        const f32x4 z0 = acc[ai][bj][m][0], z1 = acc[ai][bj][m][1]; f32x4 f0, f1, k0, k1;
#pragma unroll
                        for (int j = 0; j < 4; ++j) {
                            const float s0 = fast_sigmoid(z0[j]), s1 = fast_sigmoid(z1[j]);
                            const float la = l0[j], lc = l1[j];
                            f0[j] = 0.6931471805599453f * __builtin_amdgcn_logf(la + (1.f - la) * s0); f1[j] = 0.6931471805599453f * __builtin_amdgcn_logf(lc + (1.f - lc) * s1);
                            k0[j] = (1.f - la) * (1.f - s0); k1[j] = (1.f - lc) * (1.f - s1); }
                        { typedef _Float16 h8 __attribute__((ext_vector_type(8))); h8 hv; hv[0] = (_Float16)f0[0]; hv[1] = (_Float16)f0[1]; hv[2] = (_Float16)f0[2]; hv[3] = (_Float16)f0[3]; hv[4] = (_Float16)f1[0]; hv[5] = (_Float16)f1[1]; hv[6] = (_Float16)f1[2]; hv[7] = (_Float16)f1[3];
                          *(h8*)(lf + off) = hv; }
                        u32x4 w; w.x = cvt_pk_bf16(k0[0], k0[1]); w.y = cvt_pk_bf16(k0[2], k0[3]); w.z = cvt_pk_bf16(k1[0], k1[1]); w.w = cvt_pk_bf16(k1[2], k1[3]);
                        *(u32x4*)(kk + off) = w;
                        __builtin_amdgcn_sched_barrier(0); }
            }
        } else {
            bf16_t* O = (bf16_t*)(ws + (ty == 0 ? SC_HQ : (ty == 3 ? SC_HV : SC_HG)));
#pragma unroll
            for (int ai = 0; ai < 2; ++ai)
#pragma unroll
                for (int m = 0; m < 4; ++m) { bf16_t* rowp = O + (size_t)(row0 + ai * HALF + m * 16) * 2048 + col0;
#pragma unroll
                    for (int bj = 0; bj < 2; ++bj) { f32x4 v0 = acc[ai][bj][m][0], v1 = acc[ai][bj][m][1];
                        if (ty == 4) {
#pragma unroll
                            for (int j = 0; j < 4; ++j) { v0[j] = v0[j] * fast_sigmoid(v0[j]); v1[j] = v1[j] * fast_sigmoid(v1[j]); } }
                        u32x4 w; w.x = cvt_pk_bf16(v0[0], v0[1]); w.y = cvt_pk_bf16(v0[2], v0[3]); w.z = cvt_pk_bf16(v1[0], v1[1]); w.w = cvt_pk_bf16(v1[2], v1[3]);
                        *(u32x4*)(rowp + bj * HALF) = w; }
                    __builtin_amdgcn_sched_barrier(0); }
        }
    }
};
struct EpiQkv {
    unsigned char* ws; const float* rc; const float* rs;
    __device__ __forceinline__ void operator()(f32x4 (&acc)[2][2][4][2], const GUnit& u, int wr, int wc, int fr, int fq) const {
        const int ty = u.aux >> 3, ocol = (u.aux & 7) * 256;
        bf16_t* O = (bf16_t*)(ws + (ty == 0 ? SC_DQ : (ty == 1 ? SC_DK : SC_DV)));
        const int row0 = u.orow + wr * 64 + fr, col0 = ocol + wc * 32 + 8 * fq;
        const int prow = u.orow % TPB;
        const bool rope = ty < 2 && prow >= CTXL;
        const unsigned toff = rope ? (unsigned)((prow - CTXL + wr * 64 + fr) * 64 + 16 * wc + 4 * fq) : 0u;
        const unsigned tstep = rope ? 64u : 0u;
#pragma unroll
        for (int ai = 0; ai < 2; ++ai)
#pragma unroll
            for (int m = 0; m < 4; ++m) { const unsigned t = toff + (unsigned)(ai * HALF + m * 16) * tstep;
                f32x4 cs = *(const f32x4*)(rc + t), sn = *(const f32x4*)(rs + t);
                if (!rope) { cs = (f32x4){1.f, 1.f, 1.f, 1.f}; sn = (f32x4){0.f, 0.f, 0.f, 0.f}; }
                bf16_t* rowp = O + (size_t)(row0 + ai * HALF + m * 16) * 2048 + col0;
#pragma unroll
                for (int bj = 0; bj < 2; ++bj) { const f32x4 v0 = acc[ai][bj][m][0], v1 = acc[ai][bj][m][1]; f32x4 o0, o1;
                    o0[0] = v0[0] * cs[0] - v0[1] * sn[0]; o0[1] = v0[0] * sn[0] + v0[1] * cs[0];
                    o0[2] = v0[2] * cs[1] - v0[3] * sn[1]; o0[3] = v0[2] * sn[1] + v0[3] * cs[1];
                    o1[0] = v1[0] * cs[2] - v1[1] * sn[2]; o1[1] = v1[0] * sn[2] + v1[1] * cs[2];
                    o1[2] = v1[2] * cs[3] - v1[3] * sn[3]; o1[3] = v1[2] * sn[3] + v1[3] * cs[3];
                    u32x4 w; w.x = cvt_pk_bf16(o0[0], o0[1]); w.y = cvt_pk_bf16(o0[2], o0[3]); w.z = cvt_pk_bf16(o1[0], o1[1]); w.w = cvt_pk_bf16(o1[2], o1[3]);
                    *(u32x4*)(rowp + bj * HALF) = w; }
                asm volatile("" ::: "memory"); __builtin_amdgcn_sched_barrier(0); }
    }
};
}

namespace attn {
constexpr int D = 128, NW = 8, QBLK = 32, KVBLK = 64, LD = 2048;
constexpr float SCALE = 0.088388347648318440f;
constexpr float THR = 8.f;
constexpr size_t SHM_V = KVBLK * D * 2, SHM_K = KVBLK * D * 2, SHM_ATTN = 2 * SHM_V + 2 * SHM_K + NW * 64 * 4;
#define KSWZ(row, colB) ((row) * 256 + ((colB) ^ (((row) & 7) << 4)))
#define SBAR() __builtin_amdgcn_sched_barrier(0)
__device__ __forceinline__ int crow(int r, int hi) { return (r & 3) + 8 * (r >> 2) + 4 * hi; }
__device__ __forceinline__ unsigned cvtpk(float lo, float hi) { return cvt_pk_bf16(lo, hi); }
__device__ __forceinline__ void partialSM(f32x16& p0, f32x16& p1, float& m_reg, float& mn, float& alpha) {
  constexpr float C = SCALE * 1.4426950408889634f;
  float pmax = p0[0];
#pragma unroll
  for (int r = 1; r < 16; ++r) pmax = fmaxf(pmax, p0[r]);
#pragma unroll
  for (int r = 0; r < 16; ++r) pmax = fmaxf(pmax, p1[r]);
  { auto rr = __builtin_amdgcn_permlane32_swap(__float_as_uint(pmax), __float_as_uint(pmax), false, false);
    pmax = fmaxf(__uint_as_float(rr[0]), __uint_as_float(rr[1])); }
  if (__builtin_expect(__all(pmax - m_reg <= THR / SCALE), 1)) { mn = m_reg; alpha = 1.f; }
  else { mn = fmaxf(m_reg, pmax); alpha = __builtin_amdgcn_exp2f((m_reg - mn) * C); m_reg = mn; }
  float mnC = -mn * C;
#pragma unroll
  for (int r = 0; r < 16; ++r) p0[r] = fmaf(p0[r], C, mnC);
#pragma unroll
  for (int r = 0; r < 16; ++r) p1[r] = fmaf(p1[r], C, mnC);
#pragma unroll
  for (int r = 0; r < 16; ++r) p0[r] = __builtin_amdgcn_exp2f(p0[r]);
}
__device__ __forceinline__ void finishSM(f32x16& p0, f32x16& p1, float alpha, float& l_reg, bf16x8& pa0, bf16x8& pa1, bf16x8& pa2, bf16x8& pa3) {
#pragma unroll
  for (int r = 0; r < 16; ++r) p1[r] = __builtin_amdgcn_exp2f(p1[r]);
  float ps = 0;
#pragma unroll
  for (int r = 0; r < 16; ++r) ps += p0[r];
#pragma unroll
  for (int r = 0; r < 16; ++r) ps += p1[r];
  { auto rr = __builtin_amdgcn_permlane32_swap(__float_as_uint(ps), __float_as_uint(ps), false, false);
    ps = __uint_as_float(rr[0]) + __uint_as_float(rr[1]); }
  l_reg = l_reg * alpha + ps;
#define PK4(P, BASE, OUT) do { unsigned a0 = cvtpk(P[BASE + 0], P[BASE + 1]), a1 = cvtpk(P[BASE + 2], P[BASE + 3]);   \
    unsigned b0 = cvtpk(P[BASE + 4], P[BASE + 5]), b1 = cvtpk(P[BASE + 6], P[BASE + 7]);                              \
    auto r0 = __builtin_amdgcn_permlane32_swap(a0, b0, false, false); auto r1 = __builtin_amdgcn_permlane32_swap(a1, b1, false, false); \
    u32x4 w = {r0[0], r1[0], r0[1], r1[1]}; OUT = *reinterpret_cast<bf16x8*>(&w); } while (0)
  PK4(p0, 0, pa0); PK4(p0, 8, pa1); PK4(p1, 0, pa2); PK4(p1, 8, pa3);
#undef PK4
}
__device__ __forceinline__ void qkt(f32x16& p0, f32x16& p1, const bf16_t* Ks, const bf16x8* qr, int r32, int hi) {
  p0 = f32x16{}; p1 = f32x16{};
#pragma unroll
  for (int d0 = 0; d0 < 8; ++d0) { int cb = (d0 * 16 + hi * 8) * 2;
    bf16x8 b0 = *reinterpret_cast<const bf16x8*>((const char*)Ks + KSWZ(r32, cb));
    bf16x8 b1 = *reinterpret_cast<const bf16x8*>((const char*)Ks + KSWZ(32 + r32, cb));
    p0 = __builtin_amdgcn_mfma_f32_32x32x16_bf16(b0, qr[d0], p0, 0, 0, 0);
    p1 = __builtin_amdgcn_mfma_f32_32x32x16_bf16(b1, qr[d0], p1, 0, 0, 0); }
}
__device__ __forceinline__ int v_st(int k, int c) { const int kk = (k & ~0xC) | ((k & 4) << 1) | ((k & 8) >> 1); return ((kk >> 3) * 4 + (c >> 5)) * 512 + ((kk & 7) * 32 + (c & 31)) * 2; }
__device__ __forceinline__ int v_rd_base(int lane) { return ((lane & 3) << 3) | (((lane >> 2) & 3) << 6) | (((lane >> 4) & 1) << 5) | (((lane >> 5) & 1) << 8); }
constexpr int v_rd_off(int d0, int ks, int half) { return d0 * 512 + ks * 4096 + half * 2048; }
template <int OFF> __device__ __forceinline__ s16x4 tr_read(int vb) {
  s16x4 r; asm volatile("ds_read_b64_tr_b16 %0, %1 offset:%2" : "=&v"(r) : "v"(vb), "i"(OFF) : "memory"); return r;
}
template <int D0> __device__ __forceinline__ void pv_one(f32x16& od, int vb, bf16x8 pa0, bf16x8 pa1, bf16x8 pa2, bf16x8 pa3) {
  const s16x4 l0 = tr_read<v_rd_off(D0, 0, 0)>(vb), h0 = tr_read<v_rd_off(D0, 0, 1)>(vb), l1 = tr_read<v_rd_off(D0, 1, 0)>(vb), h1 = tr_read<v_rd_off(D0, 1, 1)>(vb);
  const s16x4 l2 = tr_read<v_rd_off(D0, 2, 0)>(vb), h2 = tr_read<v_rd_off(D0, 2, 1)>(vb), l3 = tr_read<v_rd_off(D0, 3, 0)>(vb), h3 = tr_read<v_rd_off(D0, 3, 1)>(vb);
  asm volatile("s_waitcnt lgkmcnt(0)" ::: "memory"); SBAR();
#define PK(L, H) (bf16x8){L[0], L[1], L[2], L[3], H[0], H[1], H[2], H[3]}
  od = __builtin_amdgcn_mfma_f32_32x32x16_bf16(pa0, PK(l0, h0), od, 0, 0, 0);
  od = __builtin_amdgcn_mfma_f32_32x32x16_bf16(pa1, PK(l1, h1), od, 0, 0, 0);
  od = __builtin_amdgcn_mfma_f32_32x32x16_bf16(pa2, PK(l2, h2), od, 0, 0, 0);
  od = __builtin_amdgcn_mfma_f32_32x32x16_bf16(pa3, PK(l3, h3), od, 0, 0, 0);
#undef PK
}
__device__ __forceinline__ void pv_d0(f32x16* o, int vb, bf16x8 pa0, bf16x8 pa1, bf16x8 pa2, bf16x8 pa3) {
  pv_one<0>(o[0], vb, pa0, pa1, pa2, pa3); pv_one<1>(o[1], vb, pa0, pa1, pa2, pa3); pv_one<2>(o[2], vb, pa0, pa1, pa2, pa3); pv_one<3>(o[3], vb, pa0, pa1, pa2, pa3);
}
__device__ __forceinline__ void attn_dense_body(const bf16_t* __restrict__ Qb, const bf16_t* __restrict__ Kh, const bf16_t* __restrict__ Vh,
                                                bf16_t* __restrict__ Ob, int seq, char* lds) {
  int tid_ = threadIdx.x; asm volatile("" : "+v"(tid_));
  const int tid = tid_, wid = tid >> 6, lane = tid & 63, r32 = lane & 31, hi = lane >> 5;
  bf16_t* V_lds = (bf16_t*)lds; bf16_t* K_lds = (bf16_t*)(lds + 2 * SHM_V);
  float* ws = (float*)(lds + 2 * SHM_V + 2 * SHM_K) + wid * 64; float* li_l = ws; float* al_l = ws + 32;
  float m_reg = -1e30f, l_reg = 0; f32x16 o[4] = {}; bf16x8 qr[8];
  const bf16_t* Qw = Qb + (long)(wid * QBLK + r32) * LD + hi * 8;
#pragma unroll
  for (int d0 = 0; d0 < 8; ++d0) qr[d0] = *reinterpret_cast<const bf16x8*>(Qw + d0 * 16);
  const int sr = tid >> 4, sc = (tid & 15) * 8, vst0 = v_st(sr, sc), vst1 = v_st(32 + sr, sc);
  const int vb0 = (int)(uintptr_t)V_lds + v_rd_base(lane);
  struct { bf16x8 vs0, vs1, ks0, ks1; } sr_[2];
#define SLOAD(i, k0) do { sr_[i].vs0 = *reinterpret_cast<const bf16x8*>(&Vh[(long)((k0) + sr) * LD + sc]); sr_[i].vs1 = *reinterpret_cast<const bf16x8*>(&Vh[(long)((k0) + 32 + sr) * LD + sc]); \
    sr_[i].ks0 = *reinterpret_cast<const bf16x8*>(&Kh[(long)((k0) + sr) * LD + sc]); sr_[i].ks1 = *reinterpret_cast<const bf16x8*>(&Kh[(long)((k0) + 32 + sr) * LD + sc]); } while (0)
#define SWRITE(b, i) do { *(bf16x8*)((char*)V_lds + (b) * SHM_V + vst0) = sr_[i].vs0;          \
    *(bf16x8*)((char*)V_lds + (b) * SHM_V + vst1) = sr_[i].vs1; int kc = sc * 2;               \
    *(bf16x8*)((char*)K_lds + (b) * SHM_K + KSWZ(sr, kc)) = sr_[i].ks0;                       \
    *(bf16x8*)((char*)K_lds + (b) * SHM_K + KSWZ(32 + sr, kc)) = sr_[i].ks1; } while (0)
#define SWAIT() asm volatile("s_waitcnt vmcnt(4)" ::: "memory")
#define RESC(a) do { if (__any((a) < 1.f)) { if (hi == 0) al_l[r32] = (a); asm volatile("s_waitcnt lgkmcnt(0)" ::: "memory"); \
    _Pragma("unroll") for (int d = 0; d < 4; ++d) _Pragma("unroll") for (int r = 0; r < 16; ++r) o[d][r] *= al_l[crow(r, hi)]; } } while (0)
  f32x16 pA0, pA1, pB0, pB1; float mnA, mnB, alA, alB; bf16x8 pa0, pa1, pa2, pa3; const int NT = seq / KVBLK;
  constexpr int SE = 0, SO = 1;
  SLOAD(SE, 0); asm volatile("s_waitcnt vmcnt(0)" ::: "memory"); SWRITE(0, SE); __syncthreads();
  qkt(pA0, pA1, K_lds, qr, r32, hi); partialSM(pA0, pA1, m_reg, mnA, alA);
  SLOAD(SO, KVBLK); if (2 < NT) SLOAD(SE, 2 * KVBLK);
  SWAIT(); SWRITE(1, SO); __syncthreads();
  for (int j = 1; j + 1 < NT; j += 2) {
    SBAR(); qkt(pB0, pB1, (bf16_t*)((char*)K_lds + SHM_K), qr, r32, hi);
    finishSM(pA0, pA1, alA, l_reg, pa0, pa1, pa2, pa3); SBAR();
    SLOAD(SO, (j + 2) * KVBLK); SBAR();
    pv_d0(o, vb0, pa0, pa1, pa2, pa3); partialSM(pB0, pB1, m_reg, mnB, alB);
    __syncthreads(); SWAIT(); SWRITE(0, SE);
    RESC(alB); __syncthreads();
    SBAR(); qkt(pA0, pA1, K_lds, qr, r32, hi);
    finishSM(pB0, pB1, alB, l_reg, pa0, pa1, pa2, pa3); SBAR();
    if (j + 3 < NT) SLOAD(SE, (j + 3) * KVBLK); SBAR();
    pv_d0(o, vb0 + (int)SHM_V, pa0, pa1, pa2, pa3); partialSM(pA0, pA1, m_reg, mnA, alA);
    __syncthreads(); SWAIT(); SWRITE(1, SO);
    RESC(alA); __syncthreads();
  }
  SBAR(); qkt(pB0, pB1, (bf16_t*)((char*)K_lds + SHM_K), qr, r32, hi);
  finishSM(pA0, pA1, alA, l_reg, pa0, pa1, pa2, pa3); SBAR();
  pv_d0(o, vb0, pa0, pa1, pa2, pa3); partialSM(pB0, pB1, m_reg, mnB, alB);
  __syncthreads(); RESC(alB);
  finishSM(pB0, pB1, alB, l_reg, pa0, pa1, pa2, pa3); SBAR();
  pv_d0(o, vb0 + (int)SHM_V, pa0, pa1, pa2, pa3);
  if (hi == 0) li_l[r32] = l_reg; asm volatile("s_waitcnt lgkmcnt(0)" ::: "memory");
  float rli[16];
#pragma unroll
  for (int r = 0; r < 16; ++r) rli[r] = __builtin_amdgcn_rcpf(li_l[crow(r, hi)]);
  bf16_t* Ow = Ob + (long)(wid * QBLK) * LD;
#pragma unroll
  for (int r = 0; r < 16; ++r) { int orow = crow(r, hi);
#pragma unroll
    for (int d0 = 0; d0 < 4; ++d0) Ow[(long)orow * LD + d0 * 32 + r32] = (bf16_t)f2bf(o[d0][r] * rli[r]); }
  __syncthreads();
#undef SLOAD
#undef SWRITE
#undef SWAIT
#undef RESC
}

__device__ __forceinline__ void attn_pair_body(const bf16_t* __restrict__ Qb, const bf16_t* __restrict__ Kh, const bf16_t* __restrict__ Vh, bf16_t* __restrict__ Ob, int seq, char* lds) {
  int tid_ = threadIdx.x; asm volatile("" : "+v"(tid_));
  const int tid = tid_, wid = __builtin_amdgcn_readfirstlane(tid >> 6), lane = tid & 63, r32 = lane & 31, hi = lane >> 5, ph = wid >> 2, pw = wid & 3;
  char* V_lds = lds; char* K_lds = lds + 65536;
  float* wsf = (float*)(lds + 98304) + wid * 128; float* li_l = wsf; float* al_l = wsf + 32; float* mx_l = wsf + 64;
  const float* pwsf = (const float*)(lds + 98304) + (wid ^ 4) * 128;
  u32x4* pex_own = (u32x4*)(lds + 102400) + wid * 128 + lane; const u32x4* pex_par = (const u32x4*)(lds + 102400) + (wid ^ 4) * 128 + lane;
  float m_reg = -1e30f, l_reg = 0; f32x16 o[4] = {}; bf16x8 qr[8];
  const bf16_t* Qw = Qb + (long)(pw * QBLK + r32) * LD + hi * 8;
#pragma unroll
  for (int d0 = 0; d0 < 8; ++d0) qr[d0] = *reinterpret_cast<const bf16x8*>(Qw + d0 * 16);
  const int sr = tid >> 4, sc = (tid & 15) * 8, vst0 = v_st(sr, sc), vst1 = v_st(32 + sr, sc);
  const int vb0 = (int)(uintptr_t)V_lds + ph * (int)SHM_V + v_rd_base(lane);
  const int krow = ph * 32 + r32;
  const int NT = seq / KVBLK;
  struct { bf16x8 k0, k1; } ks_[2]; struct { bf16x8 v00, v01, v10, v11; } vs_[2];
#define PLOADK(i, t) do { const long k0_ = (long)((t) < NT ? (t) : NT - 1) * KVBLK; \
    ks_[i].k0 = *reinterpret_cast<const bf16x8*>(&Kh[(k0_ + sr) * LD + sc]); ks_[i].k1 = *reinterpret_cast<const bf16x8*>(&Kh[(k0_ + 32 + sr) * LD + sc]); } while (0)
#define PLOADV(i, t) do { const long k0_ = (long)((t) < NT ? (t) : NT - 1) * KVBLK; \
    vs_[i].v00 = *reinterpret_cast<const bf16x8*>(&Vh[(k0_ + sr) * LD + sc]); vs_[i].v01 = *reinterpret_cast<const bf16x8*>(&Vh[(k0_ + 32 + sr) * LD + sc]); \
    vs_[i].v10 = *reinterpret_cast<const bf16x8*>(&Vh[(k0_ + sr) * LD + 128 + sc]); vs_[i].v11 = *reinterpret_cast<const bf16x8*>(&Vh[(k0_ + 32 + sr) * LD + 128 + sc]); } while (0)
#define PWRITEK(b, i) do { const int kc = sc * 2; *(bf16x8*)(K_lds + (b) * SHM_K + KSWZ(sr, kc)) = ks_[i].k0; *(bf16x8*)(K_lds + (b) * SHM_K + KSWZ(32 + sr, kc)) = ks_[i].k1; } while (0)
#define PWRITEV(b, i) do { *(bf16x8*)(V_lds + (b) * 2 * SHM_V + vst0) = vs_[i].v00; *(bf16x8*)(V_lds + (b) * 2 * SHM_V + vst1) = vs_[i].v01; \
    *(bf16x8*)(V_lds + (b) * 2 * SHM_V + SHM_V + vst0) = vs_[i].v10; *(bf16x8*)(V_lds + (b) * 2 * SHM_V + SHM_V + vst1) = vs_[i].v11; } while (0)
#define PK4(P, BASE, OUT) do { unsigned a0 = cvtpk(P[BASE + 0], P[BASE + 1]), a1 = cvtpk(P[BASE + 2], P[BASE + 3]);   \
    unsigned b0 = cvtpk(P[BASE + 4], P[BASE + 5]), b1 = cvtpk(P[BASE + 6], P[BASE + 7]);                              \
    auto r0 = __builtin_amdgcn_permlane32_swap(a0, b0, false, false); auto r1 = __builtin_amdgcn_permlane32_swap(a1, b1, false, false); \
    OUT = (u32x4){r0[0], r1[0], r0[1], r1[1]}; } while (0)
#define PQKT(P, b) do { bf16x8 kf[4]; P = f32x16{}; \
    _Pragma("unroll") for (int d0 = 0; d0 < 4; ++d0) kf[d0] = *reinterpret_cast<const bf16x8*>(K_lds + (b) * SHM_K + KSWZ(krow, (d0 * 16 + hi * 8) * 2)); \
    asm volatile("s_waitcnt lgkmcnt(0)" ::: "memory"); SBAR(); \
    _Pragma("unroll") for (int d0 = 0; d0 < 4; ++d0) P = __builtin_amdgcn_mfma_f32_32x32x16_bf16(kf[d0], qr[d0], P, 0, 0, 0); \
    SBAR(); \
    _Pragma("unroll") for (int d0 = 0; d0 < 4; ++d0) kf[d0] = *reinterpret_cast<const bf16x8*>(K_lds + (b) * SHM_K + KSWZ(krow, ((d0 + 4) * 16 + hi * 8) * 2)); \
    asm volatile("s_waitcnt lgkmcnt(0)" ::: "memory"); SBAR(); \
    _Pragma("unroll") for (int d0 = 0; d0 < 4; ++d0) P = __builtin_amdgcn_mfma_f32_32x32x16_bf16(kf[d0], qr[d0 + 4], P, 0, 0, 0); } while (0)
#define PROWMAX(P, PM) do { PM = P[0]; _Pragma("unroll") for (int r = 1; r < 16; ++r) PM = fmaxf(PM, P[r]); \
    { auto rr = __builtin_amdgcn_permlane32_swap(__float_as_uint(PM), __float_as_uint(PM), false, false); PM = fmaxf(__uint_as_float(rr[0]), __uint_as_float(rr[1])); } \
    if (hi == 0) mx_l[r32] = PM; } while (0)
#define PSTEP(B, j, PC, PMC, PN, PMN) do { constexpr float C = SCALE * 1.4426950408889634f; \
      \
    SBAR(); PQKT(PN, 1 - (B)); \
    float pmax = fmaxf(PMC, pwsf[64 + r32]); \
    float mn, alpha; \
    if (__builtin_expect(__all(pmax - m_reg <= THR / SCALE), 1)) { mn = m_reg; alpha = 1.f; } \
    else { mn = fmaxf(m_reg, pmax); alpha = __builtin_amdgcn_exp2f((m_reg - mn) * C); m_reg = mn; } \
    const float mnC = -mn * C; \
    _Pragma("unroll") for (int r = 0; r < 16; ++r) PC[r] = __builtin_amdgcn_exp2f(fmaf(PC[r], C, mnC)); \
    float ps = 0; _Pragma("unroll") for (int r = 0; r < 16; ++r) ps += PC[r]; \
    { auto rr = __builtin_amdgcn_permlane32_swap(__float_as_uint(ps), __float_as_uint(ps), false, false); ps = __uint_as_float(rr[0]) + __uint_as_float(rr[1]); } \
    l_reg = l_reg * alpha + ps; \
    u32x4 f0, f1; PK4(PC, 0, f0); PK4(PC, 8, f1); pex_own[0] = f0; pex_own[64] = f1; \
    const bool resc = __any(alpha < 1.f); if (resc && hi == 0) al_l[r32] = alpha; \
    asm volatile("s_waitcnt vmcnt(8)" ::: "memory"); PWRITEV(1 - (B), 1 - (B)); PLOADV(1 - (B), (j) + 3); \
    asm volatile("s_waitcnt lgkmcnt(0)" ::: "memory"); __syncthreads();              \
      \
    const u32x4 g0 = pex_par[0], g1 = pex_par[64]; \
    if (resc) { _Pragma("unroll") for (int d = 0; d < 4; ++d) _Pragma("unroll") for (int r = 0; r < 16; ++r) o[d][r] *= al_l[crow(r, hi)]; } \
    const u32x4 q0 = ph ? g0 : f0, q1 = ph ? g1 : f1, q2 = ph ? f0 : g0, q3 = ph ? f1 : g1; \
    SBAR(); pv_d0(o, vb0 + (B) * 2 * (int)SHM_V, __builtin_bit_cast(bf16x8, q0), __builtin_bit_cast(bf16x8, q1), __builtin_bit_cast(bf16x8, q2), __builtin_bit_cast(bf16x8, q3)); \
    asm volatile("s_waitcnt vmcnt(10)" ::: "memory"); PWRITEK(B, B); PLOADK(B, (j) + 4); \
    PROWMAX(PN, PMN); \
    asm volatile("s_waitcnt lgkmcnt(0)" ::: "memory"); __syncthreads();              \
  } while (0)
  f32x16 pA, pB; float pmA, pmB;
  PLOADK(0, 0); PLOADV(0, 0); PLOADK(1, 1); asm volatile("s_waitcnt vmcnt(0)" ::: "memory"); PWRITEK(0, 0); PWRITEV(0, 0); PWRITEK(1, 1);
  PLOADV(1, 1); PLOADK(0, 2); PLOADV(0, 2); PLOADK(1, 3);
  asm volatile("s_waitcnt lgkmcnt(0)" ::: "memory"); __syncthreads();
  PQKT(pA, 0); PROWMAX(pA, pmA); pB = f32x16{}; pmB = 0.f;
  asm volatile("s_waitcnt lgkmcnt(0)" ::: "memory"); __syncthreads();
#pragma unroll 1
  for (int j = 0; j < NT; j += 2) { PSTEP(0, j, pA, pmA, pB, pmB); PSTEP(1, j + 1, pB, pmB, pA, pmA); }
  if (hi == 0) li_l[r32] = l_reg; asm volatile("s_waitcnt lgkmcnt(0)" ::: "memory"); __syncthreads();
  float rli[16];
#pragma unroll
  for (int r = 0; r < 16; ++r) rli[r] = __builtin_amdgcn_rcpf(li_l[crow(r, hi)] + pwsf[crow(r, hi)]);
  bf16_t* Ow = Ob + (long)(pw * QBLK) * LD + ph * 128;
#pragma unroll
  for (int r = 0; r < 16; ++r) { int orow = crow(r, hi);
#pragma unroll
    for (int d0 = 0; d0 < 4; ++d0) Ow[(long)orow * LD + d0 * 32 + r32] = (bf16_t)f2bf(o[d0][r] * rli[r]); }
  __syncthreads();
#undef PLOADK
#undef PLOADV
#undef PWRITEK
#undef PWRITEV
#undef PK4
#undef PQKT
#undef PROWMAX
#undef PSTEP
}
}

namespace scan {
constexpr int PQ = 272, PT = 80;
constexpr int OFF_QH = 0, OFF_KT = 8704, OFF_KTT = 17408, OFF_VT = 27648, OFF_EBL = 37888, BUF = 38400;
static_assert(2 * BUF <= MISC_OFF, "scan LDS map");
constexpr float LOG2E = 1.4426950408889634f;
struct Ld { f32x2 lf[8]; unsigned q[8], k[8], v[8]; };
__device__ __forceinline__ int seq_row(int b, int dir, int s) { return b * TPB + (dir == 0 ? s : (s < CTXL ? (CTXL - 1 - s) : (TPB + CTXL - 1 - s))); }

__device__ __forceinline__ void scan_unit(LAS unsigned char* lds, const bf16_t* Q, const bf16_t* Kd, const _Float16* LFd, const bf16_t* V, bf16_t* Od, int b, int h, int dir) {
    int tid_ = threadIdx.x; asm volatile("" : "+v"(tid_));
    const int tid = tid_, lane = tid & 63, wv = __builtin_amdgcn_readfirstlane(tid >> 6);
    constexpr int NBLK = TPB / 32;
    const int rs_ = dir == 0 ? 2048 : -2048;
    if (wv >= 4) {
        const int dp = 16 * (wv - 4) + (lane & 15), tg = lane >> 4;
        Ld ra, rb;
#define SCAN_LOAD(R, blk) do { const long o0_ = (long)seq_row(b, dir, (blk) * 32 + 8 * tg) * 2048 + h * 128 + 2 * dp; \
        _Pragma("unroll") for (int i = 0; i < 8; ++i) { const long o_ = o0_ + (long)i * rs_; { typedef _Float16 h2 __attribute__((ext_vector_type(2))); const h2 l_ = *(const h2*)(LFd + o_); R.lf[i] = (f32x2){(float)l_[0], (float)l_[1]}; } R.q[i] = *(const unsigned*)(Q + o_); R.k[i] = *(const unsigned*)(Kd + o_); R.v[i] = *(const unsigned*)(V + o_); } } while (0)
#define SCAN_PREP(R, bufb) do { f32x2 cs[8]; cs[0] = R.lf[0]; _Pragma("unroll") for (int i = 1; i < 8; ++i) cs[i] = cs[i - 1] + R.lf[i]; \
        f32x2 pre = (f32x2){0.f, 0.f}, tot = (f32x2){0.f, 0.f}; \
        _Pragma("unroll") for (int g = 0; g < 4; ++g) { f32x2 t_; t_.x = __shfl(cs[7].x, (lane & 15) + 16 * g); t_.y = __shfl(cs[7].y, (lane & 15) + 16 * g); tot += t_; if (g < tg) pre += t_; } \
        unsigned ktp[8]; \
        _Pragma("unroll") for (int i = 0; i < 8; ++i) { const int tk = 8 * tg + i; const f32x2 bc = (pre + cs[i]) * LOG2E; \
            const float e0 = __builtin_amdgcn_exp2f(bc.x), e1 = __builtin_amdgcn_exp2f(bc.y), i0 = __builtin_amdgcn_exp2f(-bc.x), i1 = __builtin_amdgcn_exp2f(-bc.y); \
            *(LAS unsigned*)((bufb) + OFF_QH + tk * PQ + dp * 4) = cvt_pk_bf16(bf2f(R.q[i] & 0xffffu) * e0, bf2f(R.q[i] >> 16) * e1); \
            ktp[i] = cvt_pk_bf16(bf2f(R.k[i] & 0xffffu) * i0, bf2f(R.k[i] >> 16) * i1); \
            *(LAS unsigned*)((bufb) + OFF_KT + tk * PQ + dp * 4) = ktp[i]; } \
        u32x4 w_; \
        w_.x = (ktp[0] & 0xffffu) | (ktp[1] << 16); w_.y = (ktp[2] & 0xffffu) | (ktp[3] << 16); w_.z = (ktp[4] & 0xffffu) | (ktp[5] << 16); w_.w = (ktp[6] & 0xffffu) | (ktp[7] << 16); *(LAS u32x4*)((bufb) + OFF_KTT + (2 * dp) * PT + tg * 16) = w_; \
        w_.x = (ktp[0] >> 16) | (ktp[1] & 0xffff0000u); w_.y = (ktp[2] >> 16) | (ktp[3] & 0xffff0000u); w_.z = (ktp[4] >> 16) | (ktp[5] & 0xffff0000u); w_.w = (ktp[6] >> 16) | (ktp[7] & 0xffff0000u); *(LAS u32x4*)((bufb) + OFF_KTT + (2 * dp + 1) * PT + tg * 16) = w_; \
        w_.x = (R.v[0] & 0xffffu) | (R.v[1] << 16); w_.y = (R.v[2] & 0xffffu) | (R.v[3] << 16); w_.z = (R.v[4] & 0xffffu) | (R.v[5] << 16); w_.w = (R.v[6] & 0xffffu) | (R.v[7] << 16); *(LAS u32x4*)((bufb) + OFF_VT + (2 * dp) * PT + tg * 16) = w_; \
        w_.x = (R.v[0] >> 16) | (R.v[1] & 0xffff0000u); w_.y = (R.v[2] >> 16) | (R.v[3] & 0xffff0000u); w_.z = (R.v[4] >> 16) | (R.v[5] & 0xffff0000u); w_.w = (R.v[6] >> 16) | (R.v[7] & 0xffff0000u); *(LAS u32x4*)((bufb) + OFF_VT + (2 * dp + 1) * PT + tg * 16) = w_; \
        if (tg == 0) *(LAS f32x2*)((bufb) + OFF_EBL + dp * 8) = (f32x2){__builtin_amdgcn_exp2f(tot.x * LOG2E), __builtin_amdgcn_exp2f(tot.y * LOG2E)}; } while (0)
        SCAN_LOAD(ra, 0); SCAN_LOAD(rb, 1);
        SCAN_PREP(ra, lds); SCAN_LOAD(ra, 2);
        LDS_WAIT(); __syncthreads();
        for (int n = 0; n < NBLK; n += 2) {
            if (n + 1 < NBLK) { SCAN_PREP(rb, lds + BUF); } SCAN_LOAD(rb, (n + 3 < NBLK ? n + 3 : NBLK - 1));
            LDS_WAIT(); __syncthreads();
            if (n + 2 < NBLK) { SCAN_PREP(ra, lds); } SCAN_LOAD(ra, (n + 4 < NBLK ? n + 4 : NBLK - 1));
            LDS_WAIT(); __syncthreads();
        }
#undef SCAN_LOAD
#undef SCAN_PREP
    } else {
        const int c16 = lane & 15, q4 = lane >> 4;
        f32x4 S[2][8];
#pragma unroll
        for (int ct = 0; ct < 2; ++ct)
#pragma unroll
            for (int t = 0; t < 8; ++t) S[ct][t] = (f32x4){0.f, 0.f, 0.f, 0.f};
        __syncthreads();
#pragma unroll 1
        for (int n = 0; n < NBLK; ++n) {
            LAS unsigned char* bc_ = lds + (n & 1) * BUF;
            f32x4 c00 = (f32x4){0.f, 0.f, 0.f, 0.f}, c01 = c00, c11 = c00;
#pragma unroll
            for (int ks = 0; ks < 4; ++ks) {
                const bf16x8 k0 = *(const LAS bf16x8*)(bc_ + OFF_KT + c16 * PQ + (32 * ks + 8 * q4) * 2), k1 = *(const LAS bf16x8*)(bc_ + OFF_KT + (16 + c16) * PQ + (32 * ks + 8 * q4) * 2);
                const bf16x8 q0 = *(const LAS bf16x8*)(bc_ + OFF_QH + c16 * PQ + (32 * ks + 8 * q4) * 2), q1 = *(const LAS bf16x8*)(bc_ + OFF_QH + (16 + c16) * PQ + (32 * ks + 8 * q4) * 2);
                c00 = __builtin_amdgcn_mfma_f32_16x16x32_bf16(k0, q0, c00, 0, 0, 0); c01 = __builtin_amdgcn_mfma_f32_16x16x32_bf16(k0, q1, c01, 0, 0, 0); c11 = __builtin_amdgcn_mfma_f32_16x16x32_bf16(k1, q1, c11, 0, 0, 0); }
#pragma unroll
            for (int r = 0; r < 4; ++r) if (4 * q4 + r > c16) { c00[r] = 0.f; c11[r] = 0.f; }
            u32x4 a0w, a1w; a0w.x = cvt_pk_bf16(c00[0], c00[1]); a0w.y = cvt_pk_bf16(c00[2], c00[3]); a0w.z = 0u; a0w.w = 0u;
            a1w.x = cvt_pk_bf16(c01[0], c01[1]); a1w.y = cvt_pk_bf16(c01[2], c01[3]); a1w.z = cvt_pk_bf16(c11[0], c11[1]); a1w.w = cvt_pk_bf16(c11[2], c11[3]);
            f32x4 o0[2], o1[2];
#pragma unroll
            for (int ct = 0; ct < 2; ++ct) { const int dv = 32 * wv + 16 * ct + c16;
                u32x4 bvw; { const u32x2 lo = *(const LAS u32x2*)(bc_ + OFF_VT + dv * PT + (4 * q4) * 2), hi_ = *(const LAS u32x2*)(bc_ + OFF_VT + dv * PT + (16 + 4 * q4) * 2); bvw.x = lo.x; bvw.y = lo.y; bvw.z = hi_.x; bvw.w = hi_.y; }
                o0[ct] = __builtin_amdgcn_mfma_f32_16x16x32_bf16(__builtin_bit_cast(bf16x8, a0w), __builtin_bit_cast(bf16x8, bvw), (f32x4){0.f, 0.f, 0.f, 0.f}, 0, 0, 0);
                o1[ct] = __builtin_amdgcn_mfma_f32_16x16x32_bf16(__builtin_bit_cast(bf16x8, a1w), __builtin_bit_cast(bf16x8, bvw), (f32x4){0.f, 0.f, 0.f, 0.f}, 0, 0, 0); }
#pragma unroll
            for (int ks = 0; ks < 4; ++ks) {
                u32x4 q0w, q1w; { const u32x2 l0 = *(const LAS u32x2*)(bc_ + OFF_QH + c16 * PQ + (32 * ks + 4 * q4) * 2), h0 = *(const LAS u32x2*)(bc_ + OFF_QH + c16 * PQ + (32 * ks + 16 + 4 * q4) * 2);
                    const u32x2 l1 = *(const LAS u32x2*)(bc_ + OFF_QH + (16 + c16) * PQ + (32 * ks + 4 * q4) * 2), h1 = *(const LAS u32x2*)(bc_ + OFF_QH + (16 + c16) * PQ + (32 * ks + 16 + 4 * q4) * 2);
                    q0w.x = l0.x; q0w.y = l0.y; q0w.z = h0.x; q0w.w = h0.y; q1w.x = l1.x; q1w.y = l1.y; q1w.z = h1.x; q1w.w = h1.y; }
#pragma unroll
                for (int ct = 0; ct < 2; ++ct) {
                    u32x4 sw; sw.x = cvt_pk_bf16(S[ct][2 * ks][0], S[ct][2 * ks][1]); sw.y = cvt_pk_bf16(S[ct][2 * ks][2], S[ct][2 * ks][3]); sw.z = cvt_pk_bf16(S[ct][2 * ks + 1][0], S[ct][2 * ks + 1][1]); sw.w = cvt_pk_bf16(S[ct][2 * ks + 1][2], S[ct][2 * ks + 1][3]);
                    o0[ct] = __builtin_amdgcn_mfma_f32_16x16x32_bf16(__builtin_bit_cast(bf16x8, q0w), __builtin_bit_cast(bf16x8, sw), o0[ct], 0, 0, 0);
                    o1[ct] = __builtin_amdgcn_mfma_f32_16x16x32_bf16(__builtin_bit_cast(bf16x8, q1w), __builtin_bit_cast(bf16x8, sw), o1[ct], 0, 0, 0); } }
#pragma unroll
            for (int ct = 0; ct < 2; ++ct) { bf16_t* op_ = Od + (size_t)seq_row(b, dir, n * 32 + 4 * q4) * 2048 + h * 128 + 32 * wv + 16 * ct + c16;
#pragma unroll
                for (int r = 0; r < 4; ++r) { op_[(long)r * rs_] = (bf16_t)f2bf(o0[ct][r]); op_[(long)(16 + r) * rs_] = (bf16_t)f2bf(o1[ct][r]); } }
            { bf16x8 bv2[2];
#pragma unroll
              for (int ct = 0; ct < 2; ++ct) bv2[ct] = *(const LAS bf16x8*)(bc_ + OFF_VT + (32 * wv + 16 * ct + c16) * PT + q4 * 16);
#pragma unroll
              for (int t = 0; t < 8; ++t) { const bf16x8 ak = *(const LAS bf16x8*)(bc_ + OFF_KTT + (16 * t + c16) * PT + q4 * 16);
                  S[0][t] = __builtin_amdgcn_mfma_f32_16x16x32_bf16(ak, bv2[0], S[0][t], 0, 0, 0); S[1][t] = __builtin_amdgcn_mfma_f32_16x16x32_bf16(ak, bv2[1], S[1][t], 0, 0, 0); }
#pragma unroll
              for (int t = 0; t < 8; ++t) { const f32x4 e = *(const LAS f32x4*)(bc_ + OFF_EBL + (16 * t + 4 * q4) * 4); S[0][t] *= e; S[1][t] *= e; } }
            LDS_WAIT(); __syncthreads();
        }
    }
}
}

struct Args { const float* in[18]; float* out; unsigned char* ws; int ph_lo, ph_hi; };

struct Frame {
    LAS unsigned char* lds; unsigned char* ws; const float* const* in;
    int tid, lane, wave, G, bx, vcu;
};

template <bool ROPE_PERM>
__device__ __forceinline__ void transpose_item(const float* W, int K, int N, bf16_t* WT, LAS float* scr, int item, int lane) {
    const int nblk = N / 32, kb = item / nblk, nb = item % nblk, k0 = 64 * kb, n0 = 32 * nb;
#pragma unroll 8
    for (int i = 0; i < 32; ++i) { const int kk = 2 * i + (lane >> 5); scr[kk * 33 + (lane & 31)] = W[(size_t)(k0 + kk) * N + n0 + (lane & 31)]; }
    LDS_WAIT(); asm volatile("" ::: "memory");
    const int c = lane & 7;
#pragma unroll
    for (int j = 0; j < 4; ++j) { const int n = (lane >> 3) + 8 * j; const LAS float* s = scr + (8 * c) * 33 + n;
        u32x4 o; o.x = f2bf(s[0 * 33]) | (f2bf(s[1 * 33]) << 16); o.y = f2bf(s[2 * 33]) | (f2bf(s[3 * 33]) << 16); o.z = f2bf(s[4 * 33]) | (f2bf(s[5 * 33]) << 16); o.w = f2bf(s[6 * 33]) | (f2bf(s[7 * 33]) << 16);
        int nn = n0 + n;
        if (ROPE_PERM) { if (nn < 4096) { const int d = nn & 127, base = nn - d; nn = base + (d < 64 ? 2 * d : 2 * (d - 64) + 1); } }
        *(GAS u32x4*)(WT + (size_t)nn * K + k0 + 8 * c) = o; }
    LDS_WAIT(); asm volatile("" ::: "memory");
}

#define FRAME_OPAQUE(F) do { int t_ = threadIdx.x; asm volatile("" : "+v"(t_)); (F).tid = t_; (F).lane = t_ & 63; } while (0)
__device__ __forceinline__ void p0_prologue(Frame& F) {
    FRAME_OPAQUE(F);
    const float* const* in = F.in; unsigned char* ws = F.ws;
    {
        LAS float* scr = (LAS float*)(F.lds + F.wave * 16384);
        const int gw = F.bx * NWAVES + F.wave, NGW = F.G * NWAVES;
        constexpr int I_W1 = (DM / 64) * (HID / 32), I_W2 = (HID / 64) * (DM / 32), I_SQ = (DM / 64) * (DM / 32), I_HIN = (DM / 64) * (10240 / 32), I_QKV = (DM / 64) * (6144 / 32);
        constexpr int NIT = 4 * I_W1 + 4 * I_W2 + 4 * I_SQ + I_HIN + I_QKV;
        for (int it = gw; it < NIT; it += NGW) {
            int r = it;
            if (r < 4 * I_W1) { const int l = r / I_W1; transpose_item<false>(in[7] + (size_t)l * DM * HID, DM, HID, (bf16_t*)(ws + WS_W1T) + (size_t)l * DM * HID, scr, r % I_W1, F.lane); continue; } r -= 4 * I_W1;
            if (r < 4 * I_W2) { const int l = r / I_W2; transpose_item<false>(in[8] + (size_t)l * DM * HID, HID, DM, (bf16_t*)(ws + WS_W2T) + (size_t)l * DM * HID, scr, r % I_W2, F.lane); continue; } r -= 4 * I_W2;
            if (r < 2 * I_SQ) { const int l = r / I_SQ; transpose_item<false>(in[9] + (size_t)l * DM * DM, DM, DM, (bf16_t*)(ws + WS_FWO) + (size_t)l * DM * DM, scr, r % I_SQ, F.lane); continue; } r -= 2 * I_SQ;
            if (r < I_SQ) { transpose_item<false>(in[13], DM, DM, (bf16_t*)(ws + WS_HWO), scr, r, F.lane); continue; } r -= I_SQ;
            if (r < I_SQ) { transpose_item<false>(in[17], DM, DM, (bf16_t*)(ws + WS_DWO), scr, r, F.lane); continue; } r -= I_SQ;
            if (r < I_HIN) { transpose_item<false>(in[10], DM, 10240, (bf16_t*)(ws + WS_HWIN), scr, r, F.lane); continue; } r -= I_HIN;
            transpose_item<true>(in[14], DM, 6144, (bf16_t*)(ws + WS_DQKV), scr, r, F.lane);
        }
    }
    __syncthreads();
    {
        const size_t gt = (size_t)F.bx * NTHR + F.tid, NT_ = (size_t)F.G * NTHR;
        bf16_t* CS = (bf16_t*)(ws + WS_CS);
        for (size_t e = gt; e < (size_t)2048 * 2048 / 2; e += NT_) {
            const int r = (int)(e / 1024), l = (int)(e % 1024) * 2; const int rr = r & 1023;
            const float x0 = (float)((rr * l) & 2047) * (1.f / 2048.f), x1 = (float)((rr * (l + 1)) & 2047) * (1.f / 2048.f);
            float v0 = r < 1024 ? __builtin_amdgcn_cosf(x0) : __builtin_amdgcn_sinf(x0), v1 = r < 1024 ? __builtin_amdgcn_cosf(x1) : __builtin_amdgcn_sinf(x1);
            if (r == 1024) { v0 = 1.f; v1 = -1.f; }
            *(unsigned*)(CS + (size_t)r * 2048 + l) = cvt_pk_bf16(v0, v1);
        }
        bf16_t* C2 = (bf16_t*)(ws + WS_CS256);
        for (size_t e = gt; e < (size_t)512 * 256 / 2; e += NT_) {
            const int r = (int)(e / 128), l = (int)(e % 128) * 2; const int rr = r & 255;
            const float x0 = (float)((rr * l) & 255) * (1.f / 256.f), x1 = (float)((rr * (l + 1)) & 255) * (1.f / 256.f);
            const float v0 = r < 256 ? __builtin_amdgcn_cosf(x0) : __builtin_amdgcn_sinf(x0), v1 = r < 256 ? __builtin_amdgcn_cosf(x1) : __builtin_amdgcn_sinf(x1);
            *(unsigned*)(C2 + (size_t)r * 2048 + l) = cvt_pk_bf16(v0, v1);
        }
        bf16_t* CC = (bf16_t*)(ws + WS_CC);
        for (size_t e = gt; e < (size_t)1024 * 512 / 2; e += NT_) {
            const int j = (int)(e / 256), k = (int)(e % 256) * 2; const int kk = k & 255, cp = j & 255;
            const float x0 = (float)((cp * kk) & 255) * (1.f / 256.f), x1 = (float)((cp * (kk + 1)) & 255) * (1.f / 256.f);
            float v0, v1;
            if (j < 512) { const float sg = j < 256 ? -1.f : 1.f; v0 = k < 256 ? __builtin_amdgcn_cosf(x0) : sg * __builtin_amdgcn_sinf(x0); v1 = k < 256 ? __builtin_amdgcn_cosf(x1) : sg * __builtin_amdgcn_sinf(x1); }
            else { const bool on = ((j - 512) < 256) == (k < 256); v0 = on ? __builtin_amdgcn_cosf(x0) : 0.f; v1 = on ? __builtin_amdgcn_cosf(x1) : 0.f; }
            *(unsigned*)(CC + (size_t)j * 512 + k) = cvt_pk_bf16(v0, v1);
        }
        float* rc = (float*)(ws + WS_ROPE); float* rs = rc + 2048 * 64;
        for (size_t e = gt; e < (size_t)2048 * 64; e += NT_) {
            const int pos = (int)(e >> 6), i = (int)(e & 63);
            const float inv = powf(10000.f, -(float)(i & 31) / 32.f);
            const float ang = (float)(i < 32 ? (pos >> 6) : (pos & 63)) * inv;
            rc[e] = cosf(ang); rs[e] = sinf(ang);
        }
        float* lb = (float*)(ws + WS_LB); const float* p = in[11];
        for (size_t e = gt; e < (size_t)2 * 2048; e += NT_) {
            const float a0 = p[e], a1 = p[4096 + e], a2 = p[8192 + e], a3 = p[12288 + e];
            const float mx = fmaxf(fmaxf(a0, a1), fmaxf(a2, a3));
            const float e0 = expf(a0 - mx), e1 = expf(a1 - mx), e2 = expf(a2 - mx), e3 = expf(a3 - mx);
            lb[e] = e1 / (e0 + e1 + e2 + e3);
        }
    }
    {
        LAS float* sS = (LAS float*)F.lds;
        for (int e = F.tid; e < 2048; e += NTHR) {
#pragma unroll
            for (int r = 0; r < 5; ++r) { const float c = r < 4 ? in[1][r * 2048 + e] : in[3][e]; sS[e * 8 + r] = c / (1.f + __expf(-c)); }
        }
        LDS_WAIT(); __syncthreads();
        for (int cb = F.bx; cb < 256; cb += F.G) {
            const int col0 = cb * 192;
            const int layer = col0 / 12288, n0 = col0 % 12288;
            const float* W = in[4] + (size_t)layer * DM * 12288 + n0;
            f32x4 a[5];
#pragma unroll
            for (int r = 0; r < 5; ++r) a[r] = (f32x4){0.f, 0.f, 0.f, 0.f};
            if (F.lane < 48) {
                const int kb = F.wave * 256;
#pragma unroll 16
                for (int k = 0; k < 256; ++k) {
                    const f32x4 w = __builtin_nontemporal_load((const f32x4*)(W + (size_t)(kb + k) * 12288 + 4 * F.lane));
                    const f32x4 s4 = *(const LAS f32x4*)(sS + (kb + k) * 8); const float s5 = sS[(kb + k) * 8 + 4];
                    a[0] += w * s4[0]; a[1] += w * s4[1]; a[2] += w * s4[2]; a[3] += w * s4[3]; a[4] += w * s5;
                }
            }
            __syncthreads();
            LAS float* red = (LAS float*)(F.lds + 65536);
            if (F.lane < 48) {
#pragma unroll
                for (int r = 0; r < 5; ++r) *(LAS f32x4*)(red + (F.wave * 5 + r) * 192 + 4 * F.lane) = a[r];
            }
            LDS_WAIT(); __syncthreads();
            float* MOD = (float*)(ws + WS_MOD);
            for (int e = F.tid; e < 5 * 192; e += NTHR) { const int r = e / 192, n = e % 192; float s = 0.f;
#pragma unroll
                for (int w8 = 0; w8 < 8; ++w8) s += red[(w8 * 5 + r) * 192 + n];
                MOD[((size_t)layer * 5 + r) * 12288 + n0 + n] = s + in[5][layer * 12288 + n0 + n]; }
        }
        __syncthreads();
    }
}

__device__ __forceinline__ int mod_row(int row) { const int b = row / TPB; return (row - b * TPB) < CTXL ? 4 : b; }
__device__ __forceinline__ float sumsq8(const f32x4 (&v)[8]) { float s = 0.f;
#pragma unroll
    for (int j = 0; j < 8; ++j) s += (v[j][0] * v[j][0] + v[j][1] * v[j][1]) + (v[j][2] * v[j][2] + v[j][3] * v[j][3]);
    return wave_sum(s); }

__device__ __forceinline__ void norm_mod(const f32x4 (&x)[8], const float* g, const float* sh, const float* sc, int lane, u32x2 (&hp)[8]) {
    const float rs = rsqrtf(sumsq8(x) * (1.f / DM) + NORM_EPS);
#pragma unroll
    for (int j = 0; j < 8; ++j) { const int c = 4 * lane + 256 * j; const f32x4 gv = *(const f32x4*)(g + c), shv = *(const f32x4*)(sh + c), scv = *(const f32x4*)(sc + c);
        const f32x4 hv = (x[j] * rs) * gv * (scv + 1.f) + shv; hp[j].x = cvt_pk_bf16(hv[0], hv[1]); hp[j].y = cvt_pk_bf16(hv[2], hv[3]); }
}
template <int MODE>
__device__ __forceinline__ void row_phase(Frame& F, int layer, bool latonly, bool tr, float* dout, bool splitk) {
    FRAME_OPAQUE(F);
    unsigned char* ws = F.ws; const float* const* in = F.in;
    typedef _Float16 h4 __attribute__((ext_vector_type(4)));
    _Float16* X = (_Float16*)(ws + WS_X); const bf16_t* YO = (const bf16_t*)(ws + WS_YO); bf16_t* H = (bf16_t*)(ws + WS_H);
    const float* MOD = (const float*)(ws + WS_MOD); const float* ng = in[6];
    const int nextl = MODE == 2 ? layer + 1 : layer;
    const int nlat = NBATCH * SEQ / 32;
    const bool deal_ctx = !latonly && !tr, ctx2 = !latonly && tr;
    LAS unsigned* T = (LAS unsigned*)F.lds;
    for (int it = F.bx; it < nlat; it += F.G) {
        const int ib = it / (SEQ / 32), ip0 = (it % (SEQ / 32)) * 32;
        LAS f32x4* VL = (LAS f32x4*)F.lds;
        if (!tr) {
            __syncthreads();
            const float* gg_ = ng + (layer * 4 + (MODE == 1 ? 1 : 3)) * DM; const float* g2_ = ng + ((nextl < DEPTH ? nextl : 0) * 4 + (MODE == 1 ? 2 : 0)) * DM;
            const float* m0_ = MOD + ((size_t)layer * 5 + ib) * 12288; const float* m1_ = MOD + ((size_t)(nextl < DEPTH ? nextl : 0) * 5 + ib) * 12288;
            const float* c0_ = MOD + ((size_t)layer * 5 + 4) * 12288; const float* c1_ = MOD + ((size_t)(nextl < DEPTH ? nextl : 0) * 5 + 4) * 12288;
            const int t4 = 4 * F.tid;
            if (MODE != 0) { VL[F.tid] = *(const f32x4*)(gg_ + t4); VL[2 * 512 + F.tid] = *(const f32x4*)(m0_ + (MODE == 1 ? 2 : 5) * DM + t4); VL[5 * 512 + F.tid] = *(const f32x4*)(c0_ + (MODE == 1 ? 2 : 5) * DM + t4); }
            VL[512 + F.tid] = *(const f32x4*)(g2_ + t4);
            VL[3 * 512 + F.tid] = *(const f32x4*)(m1_ + (MODE == 1 ? 3 : 0) * DM + t4); VL[4 * 512 + F.tid] = *(const f32x4*)(m1_ + (MODE == 1 ? 4 : 1) * DM + t4);
            VL[6 * 512 + F.tid] = *(const f32x4*)(c1_ + (MODE == 1 ? 3 : 0) * DM + t4); VL[7 * 512 + F.tid] = *(const f32x4*)(c1_ + (MODE == 1 ? 4 : 1) * DM + t4);
            LDS_WAIT(); __syncthreads();
        }
#pragma unroll 1
      for (int pass = 0; pass < (ctx2 ? 2 : 1); ++pass) {
        const int q0 = pass ? 4 : 0, nq = pass ? (F.wave < 4 ? 5 : 4) : 4 + ((deal_ctx && F.wave < 4) ? 1 : 0);
        u32x2 ybn[8]; h4 xvn[8];
        if (MODE != 0 && q0 == 0) { const size_t r0_ = (size_t)(ib * TPB + CTXL + ip0 + F.wave * 4) * DM + 4 * F.lane;
#pragma unroll
            for (int j = 0; j < 8; ++j) { ybn[j] = *(const u32x2*)(YO + r0_ + 256 * j); xvn[j] = *(const h4*)(X + r0_ + 256 * j); } }
#pragma unroll 1
        for (int q = q0; q < nq; ++q) {
            int b = ib, isctx = 0, pos = ip0 + F.wave * 4 + q;
            const int rl = pass ? F.wave : F.wave * 4 + q;
            if (q == 4) { const int cr = 4 * it + F.wave; b = cr / CTXL; pos = cr % CTXL; isctx = 1; }
            const int row = b * TPB + (isctx ? 0 : CTXL) + pos;
            const int mr = isctx ? 4 : b;
            f32x4 x[8];
            if (MODE == 0) {
                const float* src = isctx ? in[2] + ((size_t)b * CTXL + pos) * DM : in[0] + ((size_t)b * SEQ + pos) * DM;
#pragma unroll
                for (int j = 0; j < 8; ++j) x[j] = *(const f32x4*)(src + 4 * F.lane + 256 * j);
            } else {
                f32x4 y[8], xc[8];
                if (q < 4) {
#pragma unroll
                    for (int j = 0; j < 8; ++j) { y[j] = (f32x4){bf2f(ybn[j].x & 0xffffu), bf2f(ybn[j].x >> 16), bf2f(ybn[j].y & 0xffffu), bf2f(ybn[j].y >> 16)}; xc[j] = __builtin_convertvector(xvn[j], f32x4); }
                    { const size_t r1_ = (size_t)(q + 1 < 4 ? row + 1 : row) * DM + 4 * F.lane;
#pragma unroll
                        for (int j = 0; j < 8; ++j) { ybn[j] = *(const u32x2*)(YO + r1_ + 256 * j); xvn[j] = *(const h4*)(X + r1_ + 256 * j); } }
                } else {
#pragma unroll
                    for (int j = 0; j < 8; ++j) xc[j] = __builtin_convertvector(*(const h4*)(X + (size_t)row * DM + 4 * F.lane + 256 * j), f32x4);
                if (splitk && isctx) {
                    const bf16_t* sl = (const bf16_t*)(ws + WS_SLAB) + ((size_t)b * CTXL + pos) * DM + 4 * F.lane;
#pragma unroll
                    for (int j = 0; j < 8; ++j) y[j] = (f32x4){0.f, 0.f, 0.f, 0.f};
#pragma unroll 2
                    for (int k = 0; k < 8; ++k) {
#pragma unroll
                        for (int j = 0; j < 8; ++j) { const u32x2 yb = *(const u32x2*)(sl + 256 * j); y[j] += (f32x4){bf2f(yb.x & 0xffffu), bf2f(yb.x >> 16), bf2f(yb.y & 0xffffu), bf2f(yb.y >> 16)}; }
                        sl += SLAB_BYTES / 2; }
                } else {
#pragma unroll
                    for (int j = 0; j < 8; ++j) { const u32x2 yb = *(const u32x2*)(YO + (size_t)row * DM + 4 * F.lane + 256 * j);
                        y[j] = (f32x4){bf2f(yb.x & 0xffffu), bf2f(yb.x >> 16), bf2f(yb.y & 0xffffu), bf2f(yb.y >> 16)}; }
                }
                }
                const float rs = rsqrtf(sumsq8(y) * (1.f / DM) + NORM_EPS);
                const float* gg = ng + (layer * 4 + (MODE == 1 ? 1 : 3)) * DM; const float* gate = MOD + ((size_t)layer * 5 + mr) * 12288 + (MODE == 1 ? 2 : 5) * DM;
#pragma unroll
                for (int j = 0; j < 8; ++j) { const int c = 4 * F.lane + 256 * j; const f32x4 xv = xc[j];
                    const f32x4 gv = tr ? *(const f32x4*)(gg + c) : VL[F.lane + 64 * j], gt = tr ? *(const f32x4*)(gate + c) : VL[(isctx ? 5 : 2) * 512 + F.lane + 64 * j];
                    x[j] = xv + gt * ((y[j] * rs) * gv); }
            }
            if (dout) {
                float* o = dout + ((size_t)b * SEQ + pos) * DM;
#pragma unroll
                for (int j = 0; j < 8; ++j) *(f32x4*)(o + 4 * F.lane + 256 * j) = x[j];
            } else {
#pragma unroll
                for (int j = 0; j < 8; ++j) *(h4*)(X + (size_t)row * DM + 4 * F.lane + 256 * j) = __builtin_convertvector(x[j], h4);
                const float* g2 = ng + (nextl * 4 + (MODE == 1 ? 2 : 0)) * DM;
                const float* sh = MOD + ((size_t)nextl * 5 + mr) * 12288 + (MODE == 1 ? 3 : 0) * DM; const float* sc = sh + DM;
                u32x2 hp[8];
                if (tr) norm_mod(x, g2, sh, sc, F.lane, hp);
                else { const float rs2 = rsqrtf(sumsq8(x) * (1.f / DM) + NORM_EPS); const int so = (isctx ? 6 : 3) * 512;
#pragma unroll
                    for (int j = 0; j < 8; ++j) { const f32x4 gv = VL[512 + F.lane + 64 * j], shv = VL[so + F.lane + 64 * j], scv = VL[so + 512 + F.lane + 64 * j];
                        const f32x4 hv = (x[j] * rs2) * gv * (scv + 1.f) + shv; hp[j].x = cvt_pk_bf16(hv[0], hv[1]); hp[j].y = cvt_pk_bf16(hv[2], hv[3]); } }
                if (!tr) {
#pragma unroll
                    for (int j = 0; j < 8; ++j) *(u32x2*)(H + (size_t)row * DM + 4 * F.lane + 256 * j) = hp[j];
                } else {
#pragma unroll
                    for (int j = 0; j < 8; ++j) { T[rl * 1025 + 2 * F.lane + 128 * j] = hp[j].x; T[rl * 1025 + 2 * F.lane + 128 * j + 1] = hp[j].y; }
                }
            }
        }
        if (tr) {
            LDS_WAIT(); __syncthreads();
            if (pass == 0) {
                bf16_t* HT = (bf16_t*)(ws + SC_HT) + (size_t)ib * 2048 * 2048 + ip0;
                for (int e = F.tid; e < 16 * 1024; e += NTHR) { const int p2 = e & 15, cp = e >> 4;
                    const unsigned a = T[(2 * p2) * 1025 + cp], c = T[(2 * p2 + 1) * 1025 + cp];
                    const unsigned lo = (a & 0xffffu) | (c << 16), hi = (a >> 16) | (c & 0xffff0000u);
                    *(unsigned*)(HT + (size_t)(2 * cp) * 2048 + 2 * p2) = lo; *(unsigned*)(HT + (size_t)(2 * cp + 1) * 2048 + 2 * p2) = hi; }
            } else {
                const int cr0 = 4 * it; bf16_t* HT = (bf16_t*)(ws + SC_HTC) + (size_t)(cr0 / CTXL) * 2048 * 2048 + (cr0 % CTXL);
                for (int cp = F.tid; cp < 1024; cp += NTHR) { const unsigned a0 = T[cp], a1 = T[1025 + cp], a2 = T[2 * 1025 + cp], a3 = T[3 * 1025 + cp];
                    u32x2 lo, hi; lo.x = (a0 & 0xffffu) | (a1 << 16); lo.y = (a2 & 0xffffu) | (a3 << 16); hi.x = (a0 >> 16) | (a1 & 0xffff0000u); hi.y = (a2 >> 16) | (a3 & 0xffff0000u);
                    *(u32x2*)(HT + (size_t)(2 * cp) * 2048) = lo; *(u32x2*)(HT + (size_t)(2 * cp + 1) * 2048) = hi; }
            }
            LDS_WAIT(); __syncthreads();
        }
      }
    }
}

__device__ __forceinline__ void hgrn_readout_phase(Frame& F) {
    FRAME_OPAQUE(F);
    unsigned char* ws = F.ws; const float* gn = F.in[12];
    const bf16_t* O0 = (const bf16_t*)(ws + SC_HO); const bf16_t* O1 = O0 + ACT_ELEMS; const bf16_t* Gs = (const bf16_t*)(ws + SC_HG); bf16_t* Y = (bf16_t*)(ws + WS_ACT);
    const int gw = F.bx * NWAVES + F.wave, NGW = F.G * NWAVES;
    const f32x4 g = *(const f32x4*)(gn + ((4 * F.lane) & 127));
    u32x2 a0n[8], a1n[8], gsn[8];
    if (gw < NROW) {
#pragma unroll
        for (int j = 0; j < 8; ++j) { const size_t off = (size_t)gw * DM + 4 * F.lane + 256 * j; a0n[j] = *(const u32x2*)(O0 + off); a1n[j] = *(const u32x2*)(O1 + off); gsn[j] = *(const u32x2*)(Gs + off); } }
    for (int row = gw; row < NROW; row += NGW) {
        u32x2 a0[8], a1[8], gs[8];
#pragma unroll
        for (int j = 0; j < 8; ++j) { a0[j] = a0n[j]; a1[j] = a1n[j]; gs[j] = gsn[j]; }
        { const int rn_ = row + NGW < NROW ? row + NGW : row;
#pragma unroll
            for (int j = 0; j < 8; ++j) { const size_t off = (size_t)rn_ * DM + 4 * F.lane + 256 * j; a0n[j] = *(const u32x2*)(O0 + off); a1n[j] = *(const u32x2*)(O1 + off); gsn[j] = *(const u32x2*)(Gs + off); } }
#pragma unroll
        for (int j = 0; j < 8; ++j) { const size_t off = (size_t)row * DM + 4 * F.lane + 256 * j;
            const f32x4 o = (f32x4){bf2f(a0[j].x & 0xffffu), bf2f(a0[j].x >> 16), bf2f(a0[j].y & 0xffffu), bf2f(a0[j].y >> 16)} + (f32x4){bf2f(a1[j].x & 0xffffu), bf2f(a1[j].x >> 16), bf2f(a1[j].y & 0xffffu), bf2f(a1[j].y >> 16)};
            float s = (o[0] * o[0] + o[1] * o[1]) + (o[2] * o[2] + o[3] * o[3]);
#pragma unroll
            for (int m = 1; m < 32; m <<= 1) s += __shfl_xor(s, m);
            const float rs = rsqrtf(s * (1.f / 128.f) + NORM_EPS);
            const float y0 = o[0] * rs * g[0] * bf2f(gs[j].x & 0xffffu), y1 = o[1] * rs * g[1] * bf2f(gs[j].x >> 16), y2 = o[2] * rs * g[2] * bf2f(gs[j].y & 0xffffu), y3 = o[3] * rs * g[3] * bf2f(gs[j].y >> 16);
            u32x2 w; w.x = cvt_pk_bf16(y0, y1); w.y = cvt_pk_bf16(y2, y3); *(u32x2*)(Y + off) = w; }
    }
}
__device__ __forceinline__ void diff_combine_phase(Frame& F, float lambda_init) {
    FRAME_OPAQUE(F);
    unsigned char* ws = F.ws; const float* lp = F.in[15]; const float* sub = F.in[16];
    const bf16_t* O0 = (const bf16_t*)(ws + SC_DO); const bf16_t* O1 = O0 + ACT_ELEMS; bf16_t* Y = (bf16_t*)(ws + WS_ACT);
    float d1 = lp[F.lane] * lp[128 + F.lane] + lp[64 + F.lane] * lp[128 + 64 + F.lane], d2 = lp[256 + F.lane] * lp[384 + F.lane] + lp[256 + 64 + F.lane] * lp[384 + 64 + F.lane];
    d1 = wave_sum(d1); d2 = wave_sum(d2);
    const float lam = expf(d1) - expf(d2) + lambda_init, osc = 1.f - lambda_init;
    const int gw = F.bx * NWAVES + F.wave, NGW = F.G * NWAVES;
    const f32x4 g = *(const f32x4*)(sub + 4 * F.lane);
    u32x2 a0n[8], a1n[8];
    if (gw < NBATCH * SEQ) { const int row = (gw >> 11) * TPB + CTXL + (gw & 2047);
#pragma unroll
        for (int j = 0; j < 8; ++j) { const size_t off = (size_t)row * DM + 4 * F.lane + 256 * j; a0n[j] = *(const u32x2*)(O0 + off); a1n[j] = *(const u32x2*)(O1 + off); } }
    for (int r = gw; r < NBATCH * SEQ; r += NGW) { const int row = (r >> 11) * TPB + CTXL + (r & 2047);
        u32x2 a0[8], a1[8];
#pragma unroll
        for (int j = 0; j < 8; ++j) { a0[j] = a0n[j]; a1[j] = a1n[j]; }
        { const int rn = r + NGW < NBATCH * SEQ ? r + NGW : r, rown = (rn >> 11) * TPB + CTXL + (rn & 2047);
#pragma unroll
            for (int j = 0; j < 8; ++j) { const size_t off = (size_t)rown * DM + 4 * F.lane + 256 * j; a0n[j] = *(const u32x2*)(O0 + off); a1n[j] = *(const u32x2*)(O1 + off); } }
#pragma unroll
        for (int j = 0; j < 8; ++j) { const size_t off = (size_t)row * DM + 4 * F.lane + 256 * j;
            const f32x4 o = (f32x4){bf2f(a0[j].x & 0xffffu), bf2f(a0[j].x >> 16), bf2f(a0[j].y & 0xffffu), bf2f(a0[j].y >> 16)} - (f32x4){bf2f(a1[j].x & 0xffffu), bf2f(a1[j].x >> 16), bf2f(a1[j].y & 0xffffu), bf2f(a1[j].y >> 16)} * lam;
            const float s = wave_sum((o[0] * o[0] + o[1] * o[1]) + (o[2] * o[2] + o[3] * o[3]));
            const float rs = rsqrtf(s * (1.f / 256.f) + NORM_EPS) * osc;
            u32x2 w; w.x = cvt_pk_bf16(o[0] * rs * g[0], o[1] * rs * g[1]); w.y = cvt_pk_bf16(o[2] * rs * g[2], o[3] * rs * g[3]); *(u32x2*)(Y + off) = w; }
    }
}

__global__ void __launch_bounds__(NTHR, 2) dit_fwd(Args args) {
    extern __shared__ __attribute__((aligned(16))) unsigned char lds_raw[];
    Frame F;
    F.lds = (LAS unsigned char*)lds_raw; F.ws = args.ws; F.in = args.in;
    F.tid = threadIdx.x; F.lane = F.tid & 63; F.wave = __builtin_amdgcn_readfirstlane(F.tid >> 6);
    F.G = gridDim.x; F.bx = blockIdx.x; F.vcu = (F.G % 8 == 0) ? (F.bx % 8) * (F.G / 8) + F.bx / 8 : F.bx;
    unsigned char* ws = args.ws;
    volatile LAS unsigned* MISC = (volatile LAS unsigned*)(F.lds + MISC_OFF);
    if (F.tid < 32) MISC[F.tid] = 0u;
    __syncthreads();
    XcdBarrier bar; bar.bar = (unsigned*)(ws + WS_CTL) + CW_BAR; bar.x = 0; bar.st = nullptr;
    if (!MK_PER_PHASE) bar = xcd_barrier_post((unsigned*)(ws + WS_CTL) + CW_BAR, MISC + 8);
    const int lo = args.ph_lo, hi = args.ph_hi;
    int pid = 0;
#ifndef PHMASK
#define PHMASK 0xFFFFF
#endif
#define EN(k) (((PHMASK) >> (k)) & 1)
#ifndef REPMASK
#define REPMASK 0
#endif
#define SITE(k) if (EN(k) && RUN) _Pragma("unroll 1") for (int rep_ = 0; rep_ < 1 + (((REPMASK) >> (k)) & 1); ++rep_, (rep_ < 1 + (((REPMASK) >> (k)) & 1)) ? xcd_barrier(bar) : (void)0)
#define RUN (lo <= pid && pid < hi)
#define SEAM do { if (!MK_PER_PHASE) { if (lo <= pid && pid + 1 < hi) xcd_barrier(bar); } ++pid; } while (0)
    using namespace pg8;
    const int G = F.G, c = F.bx;

    SITE(0) p0_prologue(F);
    SEAM;
    SITE(1) row_phase<0>(F, 0, false, true, nullptr, false);
    SEAM;

#pragma unroll 1
    for (int layer = 0; layer < DEPTH; ++layer) {
        const int mixer = layer % 3;
        const bool latonly = layer >= 2;
        const int nM = latonly ? 32 : 36;
        const bf16_t* WoT;
        if (mixer == 0) {
            const bool with_ctx = layer == 0;
            SITE(2) { SchedSeqDft S{(const char*)(ws + WS_CS), (const char*)(ws + SC_HT), (const char*)(ws + WS_CS256), (const char*)(ws + SC_HTC), with_ctx ? 1 : 0, G, c};
                EpiBf16<0> E{ws, SC_PQ, SC_PQC, 4096};
                gemm_phase<EpiBf16<0>, SchedSeqDft, true, true>(F.lds, 2048, 2048, S, E); }
            SEAM;
            SITE(3) { SchedChanDft S{(const char*)(ws + SC_PQ), (const char*)(ws + SC_PQC), (const char*)(ws + WS_CC), (const char*)(ws + WS_CC) + 512 * 512 * 2, with_ctx ? 1 : 0, G, c};
                EpiChan E{(bf16_t*)(ws + WS_ACT)};
                gemm_phase<EpiChan, SchedChanDft, true, true>(F.lds, 4096, 512, S, E); }
            SEAM;
            WoT = (const bf16_t*)(ws + WS_FWO) + (size_t)(layer / 3) * DM * DM;
        } else if (mixer == 1) {
            const bool defer_g = (G == 256);
            SITE(4) { SchedRows S{(const char*)(ws + WS_H), (const char*)(ws + WS_HWIN), 2048, 2048, 36, defer_g ? 35 : 40, 32, 0, G, c};
                EpiHgrn E{ws, (const float*)(ws + WS_LB)};
                gemm_phase<EpiHgrn, SchedRows, true, true>(F.lds, 2048, 2048, S, E); }
            SEAM;
            SITE(5) { if (defer_g && F.bx >= 128) { SchedRows S{(const char*)(ws + WS_H), (const char*)(ws + WS_HWIN) + (size_t)35 * 256 * 2048 * 2, 2048, 2048, 36, 5, 32, 0, 128, F.bx - 128, 35};
                    EpiHgrn E{ws, (const float*)(ws + WS_LB)};
                    gemm_phase<EpiHgrn, SchedRows, true, true>(F.lds, 2048, 2048, S, E); }
                for (int u = F.bx; u < 128; u += G) { const int b = u >> 5, h = (u >> 1) & 15, dir = u & 1;
                scan::scan_unit(F.lds, (const bf16_t*)(ws + SC_HQ), (const bf16_t*)(ws + SC_HK) + (size_t)dir * ACT_ELEMS, (const _Float16*)(ws + SC_HLF) + (size_t)dir * ACT_ELEMS,
                                (const bf16_t*)(ws + SC_HV), (bf16_t*)(ws + SC_HO) + (size_t)dir * ACT_ELEMS, b, h, dir); } }
            SEAM;
            SITE(6) hgrn_readout_phase(F);
            SEAM;
            WoT = (const bf16_t*)(ws + WS_HWO);
        } else {
            SITE(7) { SchedRows S{(const char*)(ws + WS_H), (const char*)(ws + WS_DQKV), 2048, 2048, 36, 24, 32, 0, G, c};
                EpiQkv E{ws, (const float*)(ws + WS_ROPE), (const float*)(ws + WS_ROPE) + 2048 * 64};
                gemm_phase<EpiQkv, SchedRows, true, true>(F.lds, 2048, 2048, S, E); }
            SEAM;
            SITE(8) {
                const float lambda_init = 0.8f - 0.6f * expf(-0.3f * (float)layer);
                const float* lp = F.in[15]; const float* sub = F.in[16];
                for (int u = F.vcu; u < 256; u += G) { const int qb = u & 7, h = (u >> 3) & 7, b = u >> 6;
                    const size_t qrow = (size_t)b * TPB + CTXL + qb * 256, krow = (size_t)b * TPB;
#pragma unroll 1
                    for (int mq = 0; mq < 4; ++mq) { const int m = mq >> 1, qh = mq & 1;
                        attn::attn_pair_body((const bf16_t*)(ws + SC_DQ) + (qrow + qh * 128) * DM + h * 256 + m * 128, (const bf16_t*)(ws + SC_DK) + krow * DM + h * 256 + m * 128,
                                             (const bf16_t*)(ws + SC_DV) + krow * DM + h * 256, (bf16_t*)(ws + SC_DO) + (size_t)m * ACT_ELEMS + (qrow + qh * 128) * DM + h * 256, TPB, (char*)lds_raw); }
                    VM_WAIT(); __syncthreads();
                    FRAME_OPAQUE(F);
                    float d1 = lp[F.lane] * lp[128 + F.lane] + lp[64 + F.lane] * lp[128 + 64 + F.lane], d2 = lp[256 + F.lane] * lp[384 + F.lane] + lp[256 + 64 + F.lane] * lp[384 + 64 + F.lane];
                    d1 = wave_sum(d1); d2 = wave_sum(d2);
                    const float lam = expf(d1) - expf(d2) + lambda_init, osc = 1.f - lambda_init;
                    const bf16_t* O0 = (const bf16_t*)(ws + SC_DO) + qrow * DM + h * 256; const bf16_t* O1 = O0 + ACT_ELEMS; bf16_t* Y = (bf16_t*)(ws + WS_ACT) + qrow * DM + h * 256;
                    const f32x4 g = *(const f32x4*)(sub + 4 * F.lane);
#pragma unroll 1
                    for (int r0 = F.wave; r0 < 256; r0 += 16 * NWAVES) {
                        u32x2 a0[16], a1[16];
#pragma unroll
                        for (int k = 0; k < 16; ++k) { const size_t off = (size_t)(r0 + k * NWAVES) * DM + 4 * F.lane; a0[k] = *(const u32x2*)(O0 + off); a1[k] = *(const u32x2*)(O1 + off); }
#pragma unroll
                        for (int k = 0; k < 16; ++k) { const size_t off = (size_t)(r0 + k * NWAVES) * DM + 4 * F.lane;
                            const f32x4 o = (f32x4){bf2f(a0[k].x & 0xffffu), bf2f(a0[k].x >> 16), bf2f(a0[k].y & 0xffffu), bf2f(a0[k].y >> 16)} - (f32x4){bf2f(a1[k].x & 0xffffu), bf2f(a1[k].x >> 16), bf2f(a1[k].y & 0xffffu), bf2f(a1[k].y >> 16)} * lam;
                            const float s = wave_sum((o[0] * o[0] + o[1] * o[1]) + (o[2] * o[2] + o[3] * o[3]));
                            const float rs = rsqrtf(s * (1.f / 256.f) + NORM_EPS) * osc;
                            u32x2 w; w.x = cvt_pk_bf16(o[0] * rs * g[0], o[1] * rs * g[1]); w.y = cvt_pk_bf16(o[2] * rs * g[2], o[3] * rs * g[3]); *(u32x2*)(Y + off) = w; } }
                    __syncthreads(); } }
            SEAM;
            WoT = (const bf16_t*)(ws + WS_DWO);
        }
        const bool splitk = !latonly && G == 256;
        SITE(10) { EpiF32 E{ws, WS_YO, WS_SLAB, SLAB_BYTES, 2048};
            if (splitk) { SchedRowsSK S{(const char*)(ws + WS_ACT), (const char*)WoT, 2048, 2048, 32, G, c}; gemm_phase<EpiF32, SchedRowsSK, true, true>(F.lds, 2048, 2048, S, E); }
            else { EpiF32 E2{ws, WS_YO, WS_YO, 0, 2048}; SchedRows S{(const char*)(ws + WS_ACT), (const char*)WoT, 2048, 2048, nM, 8, 32, latonly ? 1 : 0, G, c}; gemm_phase<EpiF32, SchedRows, true, true>(F.lds, 2048, 2048, S, E2); } }
        SEAM;
        SITE(11) row_phase<1>(F, layer, latonly, false, nullptr, splitk);
        SEAM;
        SITE(12) { SchedRows S{(const char*)(ws + WS_H), (const char*)(ws + WS_W1T) + (size_t)layer * DM * HID * 2, 2048, 2048, nM, 32, 32, latonly ? 1 : 0, G, c};
            EpiBf16<1> E{ws, SC_U, SC_U, HID};
            gemm_phase<EpiBf16<1>, SchedRows, true, true>(F.lds, 2048, 2048, S, E); }
        SEAM;
        SITE(13) { EpiF32 E{ws, WS_YO, WS_SLAB, SLAB_BYTES, 2048}; const char* W2 = (const char*)(ws + WS_W2T) + (size_t)layer * DM * HID * 2;
            if (splitk) { SchedRowsSK S{(const char*)(ws + SC_U), W2, HID, HID, 128, G, c}; gemm_phase<EpiF32, SchedRowsSK, true, true>(F.lds, HID, HID, S, E); }
            else { EpiF32 E2{ws, WS_YO, WS_YO, 0, 2048}; SchedRows S{(const char*)(ws + SC_U), W2, HID, HID, nM, 8, 128, latonly ? 1 : 0, G, c}; gemm_phase<EpiF32, SchedRows, true, true>(F.lds, HID, HID, S, E2); } }
        SEAM;
        SITE(14) row_phase<2>(F, layer, layer >= 2, layer == 2, layer == 3 ? args.out : nullptr, splitk);
        SEAM;
    }
#undef RUN
#undef SEAM
}

constexpr int N_PHASES = 2 + 7 + 8 + 7 + 7;
extern "C" void kernel_launch(void* const* d_in, const int* in_sizes, int n_in, void* d_out, int out_size, void* d_ws, size_t ws_size, hipStream_t stream) {
    static int grid = 0;
    if (grid == 0) {
        if (n_in != 18 || out_size != NBATCH * SEQ * DM || ws_size < WS_END) { fprintf(stderr, "kernel_launch: unexpected shapes (n_in %d out %d ws %zu)\n", n_in, out_size, ws_size); grid = -1; return; }
        int dev = 0, cus = 0, per_cu = 0;
        if (hipGetDevice(&dev) != hipSuccess || hipDeviceGetAttribute(&cus, hipDeviceAttributeMultiprocessorCount, dev) != hipSuccess) { grid = -1; return; }
        if (hipFuncSetAttribute((const void*)dit_fwd, hipFuncAttributeMaxDynamicSharedMemorySize, LDS_BYTES) != hipSuccess) { fprintf(stderr, "kernel_launch: hipFuncSetAttribute failed\n"); grid = -1; return; }
        if (hipOccupancyMaxActiveBlocksPerMultiprocessor(&per_cu, (const void*)dit_fwd, NTHR, LDS_BYTES) != hipSuccess || per_cu < 1) fprintf(stderr, "kernel_launch: occupancy query says %d\n", per_cu);
        (void)hipGetLastError();
        grid = cus;
    }
    if (grid < 0) return;
    (void)hipMemsetAsync((char*)d_ws + WS_CTL, 0, CTL_BYTES, stream);
    Args a{};
    for (int i = 0; i < 18; ++i) a.in[i] = (const float*)d_in[i];
    a.out = (float*)d_out; a.ws = (unsigned char*)d_ws;
#if MK_PER_PHASE
    for (int p = 0; p < N_PHASES; ++p) { a.ph_lo = p; a.ph_hi = p + 1; hipLaunchKernelGGL(dit_fwd, dim3(grid), dim3(NTHR), LDS_BYTES, stream, a); }
#else
    a.ph_lo = 0; a.ph_hi = N_PHASES; hipLaunchKernelGGL(dit_fwd, dim3(grid), dim3(NTHR), LDS_BYTES, stream, a);
#endif
    const hipError_t le = hipPeekAtLastError();
    if (le != hipSuccess) fprintf(stderr, "kernel_launch: launch failed: %s\n", hipGetErrorName(le));
}
```

```cpp
#include <hip/hip_runtime.h>
#include <cstdio>
#include <cstdint>

#ifndef MK_PER_PHASE
#define MK_PER_PHASE 0
#endif

#define LAS __attribute__((address_space(3)))
#define GAS __attribute__((address_space(1)))
typedef unsigned short bf16_t;
typedef short bf16x8 __attribute__((ext_vector_type(8)));
typedef short s16x4 __attribute__((ext_vector_type(4)));
typedef float f32x4 __attribute__((ext_vector_type(4)));
typedef float f32x2 __attribute__((ext_vector_type(2)));
typedef float f32x8 __attribute__((ext_vector_type(8)));
typedef float f32x16 __attribute__((ext_vector_type(16)));
typedef unsigned u32x4 __attribute__((ext_vector_type(4)));
typedef unsigned u32x2 __attribute__((ext_vector_type(2)));

constexpr int DM = 2048, NBATCH = 4, SEQ = 2048, CTXL = 256, TPB = SEQ + CTXL, NROW = NBATCH * TPB, DEPTH = 4, HID = 8192;
constexpr float NORM_EPS = 1e-6f;
constexpr int NWAVES = 8, NTHR = 512;

constexpr size_t MiB = 1u << 20;
constexpr size_t WS_CTL = 0, CTL_BYTES = 1 * MiB;
constexpr size_t WS_MOD = 1 * MiB;
constexpr size_t WS_LB = 2 * MiB;
constexpr size_t WS_ROPE = 2 * MiB + 64 * 1024;
constexpr size_t WS_CS = 4 * MiB;
constexpr size_t WS_CS256 = 20 * MiB;
constexpr size_t WS_CC = 22 * MiB;
constexpr size_t WS_W1T = 32 * MiB;
constexpr size_t WS_W2T = 160 * MiB;
constexpr size_t WS_FWO = 288 * MiB;
constexpr size_t WS_HWIN = 304 * MiB;
constexpr size_t WS_HWO = 344 * MiB;
constexpr size_t WS_DQKV = 352 * MiB;
constexpr size_t WS_DWO = 376 * MiB;
constexpr size_t WS_X = 384 * MiB;
constexpr size_t WS_H = 456 * MiB;
constexpr size_t WS_ACT = 492 * MiB;
constexpr size_t WS_YO = 528 * MiB;
constexpr size_t WS_SCR = 600 * MiB;
constexpr size_t WS_SLAB = 1112 * MiB;
constexpr size_t SLAB_BYTES = (size_t)NBATCH * CTXL * DM * 2;
constexpr size_t WS_END = 1176 * MiB;
constexpr size_t SC_U = WS_SCR;
constexpr size_t SC_HT = WS_SCR, SC_HTC = WS_SCR + 32 * MiB, SC_PQ = WS_SCR + 64 * MiB, SC_PQC = WS_SCR + 128 * MiB;
constexpr size_t SC_HQ = WS_SCR, SC_HV = WS_SCR + 36 * MiB, SC_HG = WS_SCR + 72 * MiB, SC_HK = WS_SCR + 108 * MiB, SC_HLF = WS_SCR + 180 * MiB, SC_HO = WS_SCR + 324 * MiB;
constexpr size_t SC_DQ = WS_SCR, SC_DK = WS_SCR + 36 * MiB, SC_DV = WS_SCR + 72 * MiB, SC_DO = WS_SCR + 108 * MiB;
constexpr size_t ACT_ELEMS = (size_t)NROW * DM;

constexpr int CW_BAR = 4096;
constexpr int LDS_BYTES = 147456;
constexpr int MISC_OFF = 131072 + 8192;

typedef __bf16 bf16x2_t __attribute__((ext_vector_type(2)));
__device__ __forceinline__ unsigned cvt_pk_bf16(float lo, float hi) { const f32x2 v = {lo, hi}; const bf16x2_t b = __builtin_convertvector(v, bf16x2_t); return __builtin_bit_cast(unsigned, b); }
__device__ __forceinline__ unsigned f2bf(float f) { unsigned u = __builtin_bit_cast(unsigned, f); return (u + 0x7fffu + ((u >> 16) & 1u)) >> 16; }
__device__ __forceinline__ float bf2f(unsigned b) { return __builtin_bit_cast(float, b << 16); }
__device__ __forceinline__ float wave_sum(float v) {
#pragma unroll
    for (int o = 1; o < 64; o <<= 1) v += __shfl_xor(v, o);
    return v;
}
#define LDS_WAIT() asm volatile("s_waitcnt lgkmcnt(0)" ::: "memory")
#define VM_WAIT() asm volatile("s_waitcnt vmcnt(0)" ::: "memory")

#define XB_TMO      128
#define XB_XCNT(j)  (256  + 64 * (j))
#define XB_XSUB(j)  (1280 + 64 * (j))
#define XB_XGEN(j)  (2304 + 64 * (j))
#define XB_TOP      3328
#define XB_TOPGEN   3392
#define XCD_BAR_WORDS 3456
#define XB_SPIN_CAP (1u << 20)
__device__ __forceinline__ unsigned xb_ld(unsigned* p)              { return __hip_atomic_load(p, __ATOMIC_RELAXED, __HIP_MEMORY_SCOPE_AGENT); }
__device__ __forceinline__ unsigned xb_add(unsigned* p, unsigned v) { return __hip_atomic_fetch_add(p, v, __ATOMIC_RELAXED, __HIP_MEMORY_SCOPE_AGENT); }
__device__ __forceinline__ unsigned xb_xcc_id() { return (unsigned)__builtin_amdgcn_s_getreg((3 << 11) | 20) & 0xFu; }
#define XB_SPIN(cond, bar) do { unsigned _sp = 0; while (cond) { __builtin_amdgcn_s_sleep(1); \
    if ((++_sp & 255u) == 0u) { if (xb_ld(&(bar)[XB_TMO])) break; if (_sp > XB_SPIN_CAP) { atomicAdd(&(bar)[XB_TMO], 1u); break; } } } } while (0)
struct XcdBarrier { unsigned* bar; unsigned x; volatile LAS unsigned* st; };
__device__ __forceinline__ XcdBarrier xcd_barrier_post(unsigned* bar, volatile LAS unsigned* st) {
    XcdBarrier b; b.bar = bar; b.x = xb_xcc_id(); b.st = st;
    if (threadIdx.x == 0) (void)xb_add(&bar[XB_XCNT(b.x)], 1u);
    return b;
}
__device__ __forceinline__ void xcd_barrier_complete(unsigned* bar, unsigned x, unsigned& nloc, unsigned& nx) {
    const unsigned G = gridDim.x * gridDim.y * gridDim.z;
    unsigned sum, cnt, mine, sp = 0u;
    for (;;) {
        sum = 0u; cnt = 0u; mine = 0u;
#pragma unroll
        for (unsigned j = 0; j < 16; ++j) { const unsigned c = xb_ld(&bar[XB_XCNT(j)]); sum += c; cnt += (c > 0u) ? 1u : 0u; mine = (j == x) ? c : mine; }
        if (sum == G) break;
        __builtin_amdgcn_s_sleep(1);
        if ((++sp & 255u) == 0u) { if (xb_ld(&bar[XB_TMO])) break; if (sp > XB_SPIN_CAP) { atomicAdd(&bar[XB_TMO], 1u); break; } }
    }
    nloc = mine > 0u ? mine : 1u; nx = cnt > 0u ? cnt : 1u;
}
__device__ __forceinline__ void xcd_barrier(const XcdBarrier& b) {
    asm volatile("s_waitcnt vmcnt(0)" ::: "memory");
    __syncthreads();
    if (threadIdx.x == 0) {
        unsigned* bar = b.bar;
        __builtin_amdgcn_s_waitcnt(0);
        unsigned nloc = b.st[0], nx = b.st[1];
        if (nloc == 0u) { xcd_barrier_complete(bar, b.x, nloc, nx); b.st[0] = nloc; b.st[1] = nx; }
        const unsigned old = xb_add(&bar[XB_XSUB(b.x)], 1u);
        const unsigned gen = old / nloc;
        if (old + 1u == (gen + 1u) * nloc) {
            __builtin_amdgcn_fence(__ATOMIC_RELEASE, "agent");
            asm volatile("s_waitcnt vmcnt(0)" ::: "memory");
            const unsigned og = xb_add(&bar[XB_TOP], 1u);
            const unsigned tg = og / nx;
            if (og + 1u == (tg + 1u) * nx) xb_add(&bar[XB_TOPGEN], 1u);
            else XB_SPIN(xb_ld(&bar[XB_TOPGEN]) == tg, bar);
            __builtin_amdgcn_fence(__ATOMIC_ACQUIRE, "agent");
            xb_add(&bar[XB_XGEN(b.x)], 1u);
            asm volatile("s_waitcnt vmcnt(0)" ::: "memory");
        } else {
            XB_SPIN(xb_ld(&bar[XB_TOPGEN]) == gen, bar);
            __builtin_amdgcn_fence(__ATOMIC_ACQUIRE, "agent");
            asm volatile("s_waitcnt vmcnt(0)" ::: "memory");
        }
    }
    __syncthreads();
}

namespace pg8 {
constexpr int BM = 256, BK = 64, HALF = 128, HTB = HALF * BK * 2, STAGE_BYTES = 8 * HTB;
__device__ __forceinline__ int lds_byte(int r, int c) { const int st = (r >> 4) * 2 + (c >> 5), rr = r & 15, cc = c & 31, ob = rr * 64 + cc * 2; return st * 1024 + (ob ^ (((ob >> 9) & 1) << 5)); }
__device__ __forceinline__ void stage_rc(int b, int& R, int& C) { const int st = b / 1024, sb = b % 1024, swz = sb ^ (((sb >> 9) & 1) << 5); R = (st >> 1) * 16 + swz / 64; C = (st & 1) * 32 + (swz % 64) / 2; }
__device__ __forceinline__ int perm32(int rho) { const int n = rho >> 4, i = rho & 15; return 8 * (i >> 2) + 4 * n + (i & 3); }

struct GUnit { const char* A; const char* B; int nt; int orow, ocol, aux; };

__device__ __forceinline__ void tile_swz(int L, int nM, int nN, int& pm, int& pn) {
    const int nwg = nM * nN; int wgid = L;
    { const int q = nwg / 8, r = nwg % 8, xcd = wgid % 8, off = wgid / 8; wgid = (xcd < r ? xcd * (q + 1) : r * (q + 1) + (xcd - r) * q) + off; }
    const int nig = 8 * nN, gid = wgid / nig, fm = gid * 8, gsz = (nM - fm) < 8 ? (nM - fm) : 8;
    pm = fm + ((wgid % nig) % gsz); pn = (wgid % nig) / gsz;
}

template <class Epi, class Sched, bool ALIGN_EPI, bool SP2>
__device__ __forceinline__ void gemm_phase(LAS unsigned char* lds, const int lda, const int ldb, const Sched& S, const Epi& E) {
    int tid_ = threadIdx.x; asm volatile("" : "+v"(tid_));
    const int tid = tid_, wid = __builtin_amdgcn_readfirstlane(tid >> 6), lane = tid & 63, wr = wid >> 2, wc = wid & 3, fr = lane & 15, fq = lane >> 4;
    unsigned voffA[2], voffB[2];
#pragma unroll
    for (int i = 0; i < 2; ++i) { int R, C; stage_rc(tid * 16 + i * 8192, R, C); const int Rb = (R & ~31) + perm32(R & 31);
        voffA[i] = (unsigned)(R * lda + C) * 2u; voffB[i] = (unsigned)(Rb * ldb + C) * 2u; }
    const size_t kstep = (size_t)(BK * 2);
    const size_t hstepA = (size_t)HALF * lda * 2, hstepB = (size_t)HALF * ldb * 2;
    const unsigned ldsw = (unsigned)wid * 1024u;
    const int aoff = lds_byte(wr * 64 + fr, fq * 8), boff = lds_byte(wc * 32 + fr, fq * 8);
#define PG8_SA(b, h) (((b) * 2 + (h)) * HTB)
#define PG8_SB(b, h) ((4 + (b) * 2 + (h)) * HTB)
#define PG8_STAGE(bufoff, gbase, voff) do { _Pragma("unroll") for (int _i = 0; _i < 2; ++_i) \
        __builtin_amdgcn_global_load_lds((const unsigned*)((const char*)(gbase) + (voff)[_i]), (LAS unsigned*)(lds + (bufoff) + ldsw + _i * 8192), 16, 0, 0); } while (0)
#define PG8_LDA(dst, b, h) do { _Pragma("unroll") for (int m = 0; m < 4; ++m) _Pragma("unroll") for (int k = 0; k < 2; ++k) dst[m][k] = *(const LAS bf16x8*)(lds + PG8_SA(b, h) + aoff + m * 2048 + k * 1024); } while (0)
#define PG8_LDB(dst, b, h) do { _Pragma("unroll") for (int n = 0; n < 2; ++n) _Pragma("unroll") for (int k = 0; k < 2; ++k) dst[n][k] = *(const LAS bf16x8*)(lds + PG8_SB(b, h) + boff + n * 2048 + k * 1024); } while (0)
#define PG8_MMA(ai, bj, At, Bt) do { __builtin_amdgcn_s_setprio(1); _Pragma("unroll") for (int m = 0; m < 4; ++m) _Pragma("unroll") for (int n = 0; n < 2; ++n) _Pragma("unroll") for (int k = 0; k < 2; ++k) \
        acc[ai][bj][m][n] = __builtin_amdgcn_mfma_f32_16x16x32_bf16(Bt[n][k], At[m][k], acc[ai][bj][m][n], 0, 0, 0); __builtin_amdgcn_s_setprio(0); } while (0)
#define PG8_WAIT_V(n) asm volatile("s_waitcnt vmcnt(" #n ")" ::: "memory")
#define PG8_WAIT_L(n) asm volatile("s_waitcnt lgkmcnt(" #n ")" ::: "memory")
#define PG8_BAR __builtin_amdgcn_s_barrier()
#define PG8_SCHED __builtin_amdgcn_sched_barrier(0)
    GUnit cur, nxt; int ui = 0;
    if (!S.next(0, cur)) return;
    f32x4 acc[2][2][4][2];
#pragma unroll
    for (int a = 0; a < 2; ++a)
#pragma unroll
        for (int b = 0; b < 2; ++b)
#pragma unroll
            for (int m = 0; m < 4; ++m)
#pragma unroll
                for (int n = 0; n < 2; ++n) acc[a][b][m][n] = (f32x4){0.f, 0.f, 0.f, 0.f};
    bf16x8 At[4][2], B0[2][2], B1[2][2];
    const char* cA = cur.A; const char* cB = cur.B;
    if constexpr (SP2) {
        PG8_STAGE(PG8_SB(0, 0), cB, voffB); PG8_STAGE(PG8_SB(0, 1), cB + hstepB, voffB); PG8_STAGE(PG8_SA(0, 0), cA, voffA); PG8_STAGE(PG8_SA(0, 1), cA + hstepA, voffA);
        if (wr == 1) PG8_BAR;
        PG8_WAIT_V(2); PG8_BAR;
        PG8_STAGE(PG8_SB(1, 0), cB + kstep, voffB); PG8_STAGE(PG8_SA(1, 0), cA + kstep, voffA); PG8_STAGE(PG8_SB(1, 1), cB + hstepB + kstep, voffB);
        PG8_WAIT_V(6); PG8_BAR;
    } else {
        PG8_STAGE(PG8_SB(0, 0), cB, voffB); PG8_STAGE(PG8_SA(0, 0), cA, voffA); PG8_STAGE(PG8_SB(0, 1), cB + hstepB, voffB); PG8_STAGE(PG8_SA(0, 1), cA + hstepA, voffA);
        if (wr == 1) PG8_BAR;
        PG8_WAIT_V(4); PG8_BAR;
        PG8_STAGE(PG8_SB(1, 0), cB + kstep, voffB); PG8_STAGE(PG8_SA(1, 0), cA + kstep, voffA); PG8_STAGE(PG8_SB(1, 1), cB + hstepB + kstep, voffB);
        PG8_WAIT_V(6); PG8_BAR;
    }
    for (;;) {
        const bool has_next = S.next(ui + 1, nxt);
        const char* nA = has_next ? nxt.A : cA; const char* nB = has_next ? nxt.B : cB;
        const int nt = cur.nt;
        for (int t = 0; t < nt; t += 2) {
            const bool last = (t == nt - 2);
            const char* a1 = cA + (size_t)(t + 1) * kstep;
            const char* a2 = last ? nA : cA + (size_t)(t + 2) * kstep; const char* b2 = last ? nB : cB + (size_t)(t + 2) * kstep;
            const char* a3 = a2 + kstep; const char* b3 = b2 + kstep;
            if constexpr (SP2) {
            PG8_LDB(B0, 0, 0); PG8_LDB(B1, 0, 1); PG8_SCHED; PG8_LDA(At, 0, 0); PG8_STAGE(PG8_SA(1, 1), a1 + hstepA, voffA);
            PG8_WAIT_V(8); PG8_WAIT_L(0); PG8_BAR; PG8_MMA(0, 0, At, B0); PG8_MMA(0, 1, At, B1); PG8_BAR; PG8_SCHED;
            PG8_LDA(At, 0, 1); PG8_STAGE(PG8_SB(0, 0), b2, voffB); PG8_STAGE(PG8_SB(0, 1), b2 + hstepB, voffB); PG8_STAGE(PG8_SA(0, 0), a2, voffA);
            PG8_WAIT_V(8); PG8_WAIT_L(0); PG8_BAR; PG8_MMA(1, 0, At, B0); PG8_MMA(1, 1, At, B1); PG8_BAR; PG8_SCHED;
            PG8_LDB(B0, 1, 0); PG8_LDB(B1, 1, 1); PG8_SCHED; PG8_LDA(At, 1, 0); PG8_STAGE(PG8_SA(0, 1), a2 + hstepA, voffA);
            PG8_WAIT_V(8); PG8_WAIT_L(0); PG8_BAR; PG8_MMA(0, 0, At, B0); PG8_MMA(0, 1, At, B1); PG8_BAR; PG8_SCHED;
            PG8_LDA(At, 1, 1); PG8_STAGE(PG8_SB(1, 0), b3, voffB); PG8_STAGE(PG8_SB(1, 1), b3 + hstepB, voffB); PG8_STAGE(PG8_SA(1, 0), a3, voffA);
            PG8_WAIT_V(8); PG8_WAIT_L(0); PG8_BAR; PG8_MMA(1, 0, At, B0); PG8_MMA(1, 1, At, B1); PG8_BAR; PG8_SCHED;
            } else {
            PG8_LDB(B0, 0, 0); PG8_SCHED; PG8_LDA(At, 0, 0); PG8_STAGE(PG8_SA(1, 1), a1 + hstepA, voffA);
            PG8_WAIT_L(8); PG8_BAR; PG8_WAIT_L(0); PG8_MMA(0, 0, At, B0); PG8_BAR; PG8_SCHED;
            PG8_LDB(B1, 0, 1); PG8_STAGE(PG8_SB(0, 0), b2, voffB);
            PG8_BAR; PG8_WAIT_L(0); PG8_MMA(0, 1, At, B1); PG8_BAR;
            PG8_LDA(At, 0, 1); PG8_STAGE(PG8_SA(0, 0), a2, voffA);
            PG8_BAR; PG8_WAIT_L(0); PG8_MMA(1, 0, At, B0); PG8_BAR; PG8_SCHED;
            PG8_STAGE(PG8_SB(0, 1), b2 + hstepB, voffB);
            PG8_WAIT_V(6); PG8_BAR; PG8_MMA(1, 1, At, B1); PG8_BAR;
            PG8_LDB(B0, 1, 0); PG8_SCHED; PG8_LDA(At, 1, 0); PG8_STAGE(PG8_SA(0, 1), a2 + hstepA, voffA);
            PG8_WAIT_L(8); PG8_BAR; PG8_WAIT_L(0); PG8_MMA(0, 0, At, B0); PG8_BAR; PG8_SCHED;
            PG8_LDB(B1, 1, 1); PG8_STAGE(PG8_SB(1, 0), b3, voffB);
            PG8_BAR; PG8_WAIT_L(0); PG8_MMA(0, 1, At, B1); PG8_BAR;
            PG8_LDA(At, 1, 1); PG8_STAGE(PG8_SA(1, 0), a3, voffA);
            PG8_BAR; PG8_WAIT_L(0); PG8_MMA(1, 0, At, B0); PG8_BAR; PG8_SCHED;
            PG8_STAGE(PG8_SB(1, 1), b3 + hstepB, voffB);
            PG8_WAIT_V(6); PG8_BAR; PG8_MMA(1, 1, At, B1); PG8_BAR;
            }
        }
        if constexpr (ALIGN_EPI) { if (wr == 0) PG8_BAR; }
        E(acc, cur, wr, wc, fr, fq);
        if (!has_next) break;
#pragma unroll
        for (int a = 0; a < 2; ++a)
#pragma unroll
            for (int b = 0; b < 2; ++b)
#pragma unroll
                for (int m = 0; m < 4; ++m)
#pragma unroll
                    for (int n = 0; n < 2; ++n) acc[a][b][m][n] = (f32x4){0.f, 0.f, 0.f, 0.f};
        cur = nxt; cA = nA; cB = nB; ++ui;
        if constexpr (ALIGN_EPI) { if (wr == 1) PG8_BAR; }
    }
    PG8_WAIT_V(0);
    if constexpr (!ALIGN_EPI) { if (wr == 0) PG8_BAR; }
    PG8_BAR;
#undef PG8_SA
#undef PG8_SB
#undef PG8_STAGE
#undef PG8_LDA
#undef PG8_LDB
#undef PG8_MMA
#undef PG8_WAIT_V
#undef PG8_WAIT_L
#undef PG8_BAR
#undef PG8_SCHED
}

__device__ __forceinline__ int panel_row(int pm, int latonly) { return latonly ? ((pm >> 3) * TPB + CTXL + (pm & 7) * 256) : pm * 256; }
struct SchedRows {
    const char* A; const char* B; int lda, ldb, nM, nN, nt, latonly, G, c; int auxoff = 0;
    __device__ __forceinline__ bool next(int i, GUnit& u) const {
        const int L = i * G + c; if (L >= nM * nN) return false;
        int pm, pn; tile_swz(L, nM, nN, pm, pn); const int row = panel_row(pm, latonly);
        u.A = A + (size_t)row * lda * 2; u.B = B + (size_t)pn * 256 * ldb * 2; u.nt = nt; u.orow = row; u.ocol = pn * 256; u.aux = pn + auxoff; return true;
    }
};
struct SchedQkv {
    const char* A; const char* B; int G, c;
    __device__ __forceinline__ bool next(int i, GUnit& u) const {
        const int L = i * G + c; int row, pn;
        if (L < 768) { int pm; tile_swz(L, 32, 24, pm, pn); row = panel_row(pm, 1); }
        else if (L < 832) { const int e = L - 768; row = (e >> 4) * TPB; pn = 8 + (e & 15); }
        else return false;
        u.A = A + (size_t)row * 2048 * 2; u.B = B + (size_t)pn * 256 * 2048 * 2; u.nt = 32; u.orow = row; u.ocol = pn * 256; u.aux = pn; return true;
    }
};
struct SchedRowsSK {
    const char* A; const char* B; int lda, ldb, ntfull, G, c;
    __device__ __forceinline__ bool next(int i, GUnit& u) const {
        if (i == 0) { int pm, pn; tile_swz(c, 32, 8, pm, pn); const int row = panel_row(pm, 1);
            u.A = A + (size_t)row * lda * 2; u.B = B + (size_t)pn * 256 * ldb * 2; u.nt = ntfull; u.orow = row; u.ocol = pn * 256; u.aux = 0; return true; }
        if (i == 1) { const int id = c >> 3, ks = c & 7, b = id >> 3, pn = id & 7, kof = ks * (ntfull / 8) * 64;
            u.A = A + ((size_t)(b * TPB) * lda + kof) * 2; u.B = B + ((size_t)pn * 256 * ldb + kof) * 2; u.nt = ntfull / 8; u.orow = b * CTXL; u.ocol = pn * 256; u.aux = 1 + ks; return true; }
        return false;
    }
};
struct SchedSeqDft {
    const char* CS; const char* HT; const char* CS256; const char* HTC; int with_ctx, G, c;
    __device__ __forceinline__ bool next(int i, GUnit& u) const {
        const int L = i * G + c;
        if (L < 256) { int pm, pn; tile_swz(L, 32, 8, pm, pn); const int b = pm >> 3, p = pm & 7;
            u.A = CS + (size_t)p * 256 * 2048 * 2; u.B = HT + ((size_t)b * 2048 + pn * 256) * 2048 * 2; u.nt = 32; u.orow = b * 1024 + (p & 3) * 256; u.ocol = pn * 512 + (p >> 2) * 256; u.aux = 0; return true; }
        if (with_ctx && L < 320) { const int e = L - 256, b = e >> 4, p = (e >> 3) & 1, pn = e & 7;
            u.A = CS256 + (size_t)p * 256 * 2048 * 2; u.B = HTC + ((size_t)b * 2048 + pn * 256) * 2048 * 2; u.nt = 4; u.orow = b * 256; u.ocol = pn * 512 + p * 256; u.aux = 1; return true; }
        return false;
    }
};
struct SchedChanDft {
    const char* PQ; const char* PQC; const char* CC2; const char* CC3; int with_ctx, G, c;
    __device__ __forceinline__ bool next(int i, GUnit& u) const {
        const int L = i * G + c;
        if (L < 256) { int pm, pn; tile_swz(L, 16, 16, pm, pn); const int b = pm >> 2, lt = pm & 3, g = pn >> 1, sgn = pn & 1;
            u.A = PQ + (((size_t)b * 1024 + lt * 256) * 4096 + g * 512) * 2; u.B = CC2 + (size_t)sgn * 256 * 512 * 2; u.nt = 8; u.ocol = g * 256;
            u.orow = b * TPB + CTXL + (sgn ? SEQ - lt * 256 : lt * 256); u.aux = (lt == 0 ? 1 : 0) | (sgn ? 2 : 0); return true; }
        if (L < 320) { const int e = L - 256, b = e >> 4, g = (e >> 1) & 7, half = e & 1;
            u.A = PQ + (((size_t)b * 1024) * 4096 + g * 512) * 2; u.B = CC3 + (size_t)half * 256 * 512 * 2; u.nt = 8; u.ocol = g * 256; u.orow = b * TPB + CTXL + half * 1024; u.aux = 4; return true; }
        if (with_ctx && L < 352) { const int e = L - 320, b = e >> 3, g = e & 7;
            u.A = PQC + ((size_t)b * 256 * 4096 + g * 512) * 2; u.B = CC2; u.nt = 8; u.orow = b * TPB; u.ocol = g * 256; u.aux = 0; return true; }
        return false;
    }
};

template <int ACT  > struct EpiBf16 {
    unsigned char* ws; size_t off0, off1; int ldc;
    __device__ __forceinline__ void operator()(f32x4 (&acc)[2][2][4][2], const GUnit& u, int wr, int wc, int fr, int fq) const {
        bf16_t* base = (bf16_t*)(ws + (u.aux ? off1 : off0));
        const int row0 = u.orow + wr * 64 + fr, col0 = u.ocol + wc * 32 + 8 * fq;
#pragma unroll
        for (int ai = 0; ai < 2; ++ai)
#pragma unroll
            for (int m = 0; m < 4; ++m) { bf16_t* rowp = base + (size_t)(row0 + ai * HALF + m * 16) * ldc + col0;
#pragma unroll
                for (int bj = 0; bj < 2; ++bj) { f32x4 v0 = acc[ai][bj][m][0], v1 = acc[ai][bj][m][1];
                    if (ACT == 1) {
#pragma unroll
                        for (int j = 0; j < 4; ++j) { const float a = fmaxf(v0[j], 0.f), b = fmaxf(v1[j], 0.f); v0[j] = a * a; v1[j] = b * b; } }
                    u32x4 w; w.x = cvt_pk_bf16(v0[0], v0[1]); w.y = cvt_pk_bf16(v0[2], v0[3]); w.z = cvt_pk_bf16(v1[0], v1[1]); w.w = cvt_pk_bf16(v1[2], v1[3]);
                    *(u32x4*)(rowp + bj * HALF) = w; } }
    }
};
struct EpiChan {
    bf16_t* O;
    __device__ __forceinline__ void operator()(f32x4 (&acc)[2][2][4][2], const GUnit& u, int wr, int wc, int fr, int fq) const {
        const int col0 = u.ocol + wc * 32 + 8 * fq;
#pragma unroll
        for (int ai = 0; ai < 2; ++ai)
#pragma unroll
            for (int m = 0; m < 4; ++m) { const int r = ai * HALF + wr * 64 + m * 16 + fr;
                const bool on = (u.aux & 4) ? (r == 0) : !((u.aux & 1) && r == 0);
                const int drow = (u.aux & 4) ? u.orow : ((u.aux & 2) ? u.orow - r : u.orow + r);
                bf16_t* rowp = O + (size_t)drow * 2048 + col0;
                if (on) {
#pragma unroll
                    for (int bj = 0; bj < 2; ++bj) { const f32x4 v0 = acc[ai][bj][m][0], v1 = acc[ai][bj][m][1];
                        u32x4 w; w.x = cvt_pk_bf16(v0[0], v0[1]); w.y = cvt_pk_bf16(v0[2], v0[3]); w.z = cvt_pk_bf16(v1[0], v1[1]); w.w = cvt_pk_bf16(v1[2], v1[3]);
                        *(u32x4*)(rowp + bj * HALF) = w; } } }
    }
};
struct EpiF32 {
    unsigned char* ws; size_t off0, off1, slab; int ldc;
    __device__ __forceinline__ void operator()(f32x4 (&acc)[2][2][4][2], const GUnit& u, int wr, int wc, int fr, int fq) const {
        const int row0 = u.orow + wr * 64 + fr, col0 = u.ocol + wc * 32 + 8 * fq;
        if (u.aux && slab) {
            bf16_t* C = (bf16_t*)(ws + off1 + (size_t)(u.aux - 1) * slab);
#pragma unroll
            for (int ai = 0; ai < 2; ++ai)
#pragma unroll
                for (int m = 0; m < 4; ++m) { bf16_t* rowp = C + (size_t)(row0 + ai * HALF + m * 16) * ldc + col0;
#pragma unroll
                    for (int bj = 0; bj < 2; ++bj) { const f32x4 v0 = acc[ai][bj][m][0], v1 = acc[ai][bj][m][1];
                        u32x4 w; w.x = cvt_pk_bf16(v0[0], v0[1]); w.y = cvt_pk_bf16(v0[2], v0[3]); w.z = cvt_pk_bf16(v1[0], v1[1]); w.w = cvt_pk_bf16(v1[2], v1[3]);
                        *(u32x4*)(rowp + bj * HALF) = w; } }
        } else {
            bf16_t* C = (bf16_t*)(ws + off0);
#pragma unroll
            for (int ai = 0; ai < 2; ++ai)
#pragma unroll
                for (int m = 0; m < 4; ++m) { bf16_t* rowp = C + (size_t)(row0 + ai * HALF + m * 16) * ldc + col0;
#pragma unroll
                    for (int bj = 0; bj < 2; ++bj) { const f32x4 v0 = acc[ai][bj][m][0], v1 = acc[ai][bj][m][1];
                        u32x4 w; w.x = cvt_pk_bf16(v0[0], v0[1]); w.y = cvt_pk_bf16(v0[2], v0[3]); w.z = cvt_pk_bf16(v1[0], v1[1]); w.w = cvt_pk_bf16(v1[2], v1[3]);
                        *(u32x4*)(rowp + bj * HALF) = w; } }
        }
    }
};
__device__ __forceinline__ float fast_sigmoid(float z) { return __builtin_amdgcn_rcpf(1.f + __builtin_amdgcn_exp2f(-1.4426950408889634f * z)); }
struct EpiHgrn {
    unsigned char* ws; const float* lb;
    __device__ __forceinline__ void operator()(f32x4 (&acc)[2][2][4][2], const GUnit& u, int wr, int wc, int fr, int fq) const {
        const int ty = u.aux >> 3, ocol = (u.aux & 7) * 256;
        const int row0 = u.orow + wr * 64 + fr, col0 = ocol + wc * 32 + 8 * fq;
        if (ty == 1 || ty == 2) {
            const int dir = ty - 1; _Float16* lf = (_Float16*)(ws + SC_HLF) + (size_t)dir * ACT_ELEMS; bf16_t* kk = (bf16_t*)(ws + SC_HK) + (size_t)dir * ACT_ELEMS;
#pragma unroll
            for (int bj = 0; bj < 2; ++bj) {
                const f32x4 l0 = *(const f32x4*)(lb + dir * 2048 + col0 + bj * HALF), l1 = *(const f32x4*)(lb + dir * 2048 + col0 + bj * HALF + 4);
#pragma unroll
                for (int ai = 0; ai < 2; ++ai)
#pragma unroll
                    for (int m = 0; m < 4; ++m) { const size_t off = (size_t)(row0 + ai * HALF + m * 16) * 2048 + col0 + bj * HALF;
                        const f32x4 z0 = acc[ai][bj][m][0], z1 = acc[ai][bj][m][1]; f32x4 f0, f1, k0, k1;
#pragma unroll
                        for (int j = 0; j < 4; ++j) {
                            const float s0 = fast_sigmoid(z0[j]), s1 = fast_sigmoid(z1[j]);
                            const float la = l0[j], lc = l1[j];
                            f0[j] = 0.6931471805599453f * __builtin_amdgcn_logf(la + (1.f - la) * s0); f1[j] = 0.6931471805599453f * __builtin_amdgcn_logf(lc + (1.f - lc) * s1);
                            k0[j] = (1.f - la) * (1.f - s0); k1[j] = (1.f - lc) * (1.f - s1); }
                        { typedef _Float16 h8 __attribute__((ext_vector_type(8))); h8 hv; hv[0] = (_Float16)f0[0]; hv[1] = (_Float16)f0[1]; hv[2] = (_Float16)f0[2]; hv[3] = (_Float16)f0[3]; hv[4] = (_Float16)f1[0]; hv[5] = (_Float16)f1[1]; hv[6] = (_Float16)f1[2]; hv[7] = (_Float16)f1[3];
                          *(h8*)(lf + off) = hv; }
                        u32x4 w; w.x = cvt_pk_bf16(k0[0], k0[1]); w.y = cvt_pk_bf16(k0[2], k0[3]); w.z = cvt_pk_bf16(k1[0], k1[1]); w.w = cvt_pk_bf16(k1[2], k1[3]);
                        *(u32x4*)(kk + off) = w;
                        __builtin_amdgcn_sched_barrier(0); }
            }
        } else {
            bf16_t* O = (bf16_t*)(ws + (ty == 0 ? SC_HQ : (ty == 3 ? SC_HV : SC_HG)));
#pragma unroll
            for (int ai = 0; ai < 2; ++ai)
#pragma unroll
                for (int m = 0; m < 4; ++m) { bf16_t* rowp = O + (size_t)(row0 + ai * HALF + m * 16) * 2048 + col0;
#pragma unroll
                    for (int bj = 0; bj < 2; ++bj) { f32x4 v0 = acc[ai][bj][m][0], v1 = acc[ai][bj][m][1];
                        if (ty == 4) {
#pragma unroll
                            for (int j = 0; j < 4; ++j) { v0[j] = v0[j] * fast_sigmoid(v0[j]); v1[j] = v1[j] * fast_sigmoid(v1[j]); } }
                        u32x4 w; w.x = cvt_pk_bf16(v0[0], v0[1]); w.y = cvt_pk_bf16(v0[2], v0[3]); w.z = cvt_pk_bf16(v1[0], v1[1]); w.w = cvt_pk_bf16(v1[2], v1[3]);
                        *(u32x4*)(rowp + bj * HALF) = w; }
                    __builtin_amdgcn_sched_barrier(0); }
        }
    }
};
struct EpiQkv {
    unsigned char* ws; const float* rc; const float* rs;
    __device__ __forceinline__ void operator()(f32x4 (&acc)[2][2][4][2], const GUnit& u, int wr, int wc, int fr, int fq) const {
        const int ty = u.aux >> 3, ocol = (u.aux & 7) * 256;
        bf16_t* O = (bf16_t*)(ws + (ty == 0 ? SC_DQ : (ty == 1 ? SC_DK : SC_DV)));
        const int row0 = u.orow + wr * 64 + fr, col0 = ocol + wc * 32 + 8 * fq;
        const int prow = u.orow % TPB;
        const bool rope = ty < 2 && prow >= CTXL;
        const unsigned toff = rope ? (unsigned)((prow - CTXL + wr * 64 + fr) * 64 + 16 * wc + 4 * fq) : 0u;
        const unsigned tstep = rope ? 64u : 0u;
#pragma unroll
        for (int ai = 0; ai < 2; ++ai)
#pragma unroll
            for (int m = 0; m < 4; ++m) { const unsigned t = toff + (unsigned)(ai * HALF + m * 16) * tstep;
                f32x4 cs = *(const f32x4*)(rc + t), sn = *(const f32x4*)(rs + t);
                if (!rope) { cs = (f32x4){1.f, 1.f, 1.f, 1.f}; sn = (f32x4){0.f, 0.f, 0.f, 0.f}; }
                bf16_t* rowp = O + (size_t)(row0 + ai * HALF + m * 16) * 2048 + col0;
#pragma unroll
                for (int bj = 0; bj < 2; ++bj) { const f32x4 v0 = acc[ai][bj][m][0], v1 = acc[ai][bj][m][1]; f32x4 o0, o1;
                    o0[0] = v0[0] * cs[0] - v0[1] * sn[0]; o0[1] = v0[0] * sn[0] + v0[1] * cs[0];
                    o0[2] = v0[2] * cs[1] - v0[3] * sn[1]; o0[3] = v0[2] * sn[1] + v0[3] * cs[1];
                    o1[0] = v1[0] * cs[2] - v1[1] * sn[2]; o1[1] = v1[0] * sn[2] + v1[1] * cs[2];
                    o1[2] = v1[2] * cs[3] - v1[3] * sn[3]; o1[3] = v1[2] * sn[3] + v1[3] * cs[3];
                    u32x4 w; w.x = cvt_pk_bf16(o0[0], o0[1]); w.y = cvt_pk_bf16(o0[2], o0[3]); w.z = cvt_pk_bf16(o1[0], o1[1]); w.w = cvt_pk_bf16(o1[2], o1[3]);
                    *(u32x4*)(rowp + bj * HALF) = w; }
                asm volatile("" ::: "memory"); __builtin_amdgcn_sched_barrier(0); }
    }
};
}

namespace attn {
constexpr int D = 128, NW = 8, QBLK = 32, KVBLK = 64, LD = 2048;
constexpr float SCALE = 0.088388347648318440f;
constexpr float THR = 8.f;
constexpr size_t SHM_V = KVBLK * D * 2, SHM_K = KVBLK * D * 2, SHM_ATTN = 2 * SHM_V + 2 * SHM_K + NW * 64 * 4;
#define KSWZ(row, colB) ((row) * 256 + ((colB) ^ (((row) & 7) << 4)))
#define SBAR() __builtin_amdgcn_sched_barrier(0)
__device__ __forceinline__ int crow(int r, int hi) { return (r & 3) + 8 * (r >> 2) + 4 * hi; }
__device__ __forceinline__ unsigned cvtpk(float lo, float hi) { return cvt_pk_bf16(lo, hi); }
__device__ __forceinline__ void partialSM(f32x16& p0, f32x16& p1, float& m_reg, float& mn, float& alpha) {
  constexpr float C = SCALE * 1.4426950408889634f;
  float pmax = p0[0];
#pragma unroll
  for (int r = 1; r < 16; ++r) pmax = fmaxf(pmax, p0[r]);
#pragma unroll
  for (int r = 0; r < 16; ++r) pmax = fmaxf(pmax, p1[r]);
  { auto rr = __builtin_amdgcn_permlane32_swap(__float_as_uint(pmax), __float_as_uint(pmax), false, false);
    pmax = fmaxf(__uint_as_float(rr[0]), __uint_as_float(rr[1])); }
  if (__builtin_expect(__all(pmax - m_reg <= THR / SCALE), 1)) { mn = m_reg; alpha = 1.f; }
  else { mn = fmaxf(m_reg, pmax); alpha = __builtin_amdgcn_exp2f((m_reg - mn) * C); m_reg = mn; }
  float mnC = -mn * C;
#pragma unroll
  for (int r = 0; r < 16; ++r) p0[r] = fmaf(p0[r], C, mnC);
#pragma unroll
  for (int r = 0; r < 16; ++r) p1[r] = fmaf(p1[r], C, mnC);
#pragma unroll
  for (int r = 0; r < 16; ++r) p0[r] = __builtin_amdgcn_exp2f(p0[r]);
}
__device__ __forceinline__ void finishSM(f32x16& p0, f32x16& p1, float alpha, float& l_reg, bf16x8& pa0, bf16x8& pa1, bf16x8& pa2, bf16x8& pa3) {
#pragma unroll
  for (int r = 0; r < 16; ++r) p1[r] = __builtin_amdgcn_exp2f(p1[r]);
  float ps = 0;
#pragma unroll
  for (int r = 0; r < 16; ++r) ps += p0[r];
#pragma unroll
  for (int r = 0; r < 16; ++r) ps += p1[r];
  { auto rr = __builtin_amdgcn_permlane32_swap(__float_as_uint(ps), __float_as_uint(ps), false, false);
    ps = __uint_as_float(rr[0]) + __uint_as_float(rr[1]); }
  l_reg = l_reg * alpha + ps;
#define PK4(P, BASE, OUT) do { unsigned a0 = cvtpk(P[BASE + 0], P[BASE + 1]), a1 = cvtpk(P[BASE + 2], P[BASE + 3]);   \
    unsigned b0 = cvtpk(P[BASE + 4], P[BASE + 5]), b1 = cvtpk(P[BASE + 6], P[BASE + 7]);                              \
    auto r0 = __builtin_amdgcn_permlane32_swap(a0, b0, false, false); auto r1 = __builtin_amdgcn_permlane32_swap(a1, b1, false, false); \
    u32x4 w = {r0[0], r1[0], r0[1], r1[1]}; OUT = *reinterpret_cast<bf16x8*>(&w); } while (0)
  PK4(p0, 0, pa0); PK4(p0, 8, pa1); PK4(p1, 0, pa2); PK4(p1, 8, pa3);
#undef PK4
}
__device__ __forceinline__ void qkt(f32x16& p0, f32x16& p1, const bf16_t* Ks, const bf16x8* qr, int r32, int hi) {
  p0 = f32x16{}; p1 = f32x16{};
#pragma unroll
  for (int d0 = 0; d0 < 8; ++d0) { int cb = (d0 * 16 + hi * 8) * 2;
    bf16x8 b0 = *reinterpret_cast<const bf16x8*>((const char*)Ks + KSWZ(r32, cb));
    bf16x8 b1 = *reinterpret_cast<const bf16x8*>((const char*)Ks + KSWZ(32 + r32, cb));
    p0 = __builtin_amdgcn_mfma_f32_32x32x16_bf16(b0, qr[d0], p0, 0, 0, 0);
    p1 = __builtin_amdgcn_mfma_f32_32x32x16_bf16(b1, qr[d0], p1, 0, 0, 0); }
}
__device__ __forceinline__ int v_st(int k, int c) { const int kk = (k & ~0xC) | ((k & 4) << 1) | ((k & 8) >> 1); return ((kk >> 3) * 4 + (c >> 5)) * 512 + ((kk & 7) * 32 + (c & 31)) * 2; }
__device__ __forceinline__ int v_rd_base(int lane) { return ((lane & 3) << 3) | (((lane >> 2) & 3) << 6) | (((lane >> 4) & 1) << 5) | (((lane >> 5) & 1) << 8); }
constexpr int v_rd_off(int d0, int ks, int half) { return d0 * 512 + ks * 4096 + half * 2048; }
template <int OFF> __device__ __forceinline__ s16x4 tr_read(int vb) {
  s16x4 r; asm volatile("ds_read_b64_tr_b16 %0, %1 offset:%2" : "=&v"(r) : "v"(vb), "i"(OFF) : "memory"); return r;
}
template <int D0> __device__ __forceinline__ void pv_one(f32x16& od, int vb, bf16x8 pa0, bf16x8 pa1, bf16x8 pa2, bf16x8 pa3) {
  const s16x4 l0 = tr_read<v_rd_off(D0, 0, 0)>(vb), h0 = tr_read<v_rd_off(D0, 0, 1)>(vb), l1 = tr_read<v_rd_off(D0, 1, 0)>(vb), h1 = tr_read<v_rd_off(D0, 1, 1)>(vb);
  const s16x4 l2 = tr_read<v_rd_off(D0, 2, 0)>(vb), h2 = tr_read<v_rd_off(D0, 2, 1)>(vb), l3 = tr_read<v_rd_off(D0, 3, 0)>(vb), h3 = tr_read<v_rd_off(D0, 3, 1)>(vb);
  asm volatile("s_waitcnt lgkmcnt(0)" ::: "memory"); SBAR();
#define PK(L, H) (bf16x8){L[0], L[1], L[2], L[3], H[0], H[1], H[2], H[3]}
  od = __builtin_amdgcn_mfma_f32_32x32x16_bf16(pa0, PK(l0, h0), od, 0, 0, 0);
  od = __builtin_amdgcn_mfma_f32_32x32x16_bf16(pa1, PK(l1, h1), od, 0, 0, 0);
  od = __builtin_amdgcn_mfma_f32_32x32x16_bf16(pa2, PK(l2, h2), od, 0, 0, 0);
  od = __builtin_amdgcn_mfma_f32_32x32x16_bf16(pa3, PK(l3, h3), od, 0, 0, 0);
#undef PK
}
__device__ __forceinline__ void pv_d0(f32x16* o, int vb, bf16x8 pa0, bf16x8 pa1, bf16x8 pa2, bf16x8 pa3) {
  pv_one<0>(o[0], vb, pa0, pa1, pa2, pa3); pv_one<1>(o[1], vb, pa0, pa1, pa2, pa3); pv_one<2>(o[2], vb, pa0, pa1, pa2, pa3); pv_one<3>(o[3], vb, pa0, pa1, pa2, pa3);
}
__device__ __forceinline__ void attn_dense_body(const bf16_t* __restrict__ Qb, const bf16_t* __restrict__ Kh, const bf16_t* __restrict__ Vh,
                                                bf16_t* __restrict__ Ob, int seq, char* lds) {
  int tid_ = threadIdx.x; asm volatile("" : "+v"(tid_));
  const int tid = tid_, wid = tid >> 6, lane = tid & 63, r32 = lane & 31, hi = lane >> 5;
  bf16_t* V_lds = (bf16_t*)lds; bf16_t* K_lds = (bf16_t*)(lds + 2 * SHM_V);
  float* ws = (float*)(lds + 2 * SHM_V + 2 * SHM_K) + wid * 64; float* li_l = ws; float* al_l = ws + 32;
  float m_reg = -1e30f, l_reg = 0; f32x16 o[4] = {}; bf16x8 qr[8];
  const bf16_t* Qw = Qb + (long)(wid * QBLK + r32) * LD + hi * 8;
#pragma unroll
  for (int d0 = 0; d0 < 8; ++d0) qr[d0] = *reinterpret_cast<const bf16x8*>(Qw + d0 * 16);
  const int sr = tid >> 4, sc = (tid & 15) * 8, vst0 = v_st(sr, sc), vst1 = v_st(32 + sr, sc);
  const int vb0 = (int)(uintptr_t)V_lds + v_rd_base(lane);
  struct { bf16x8 vs0, vs1, ks0, ks1; } sr_[2];
#define SLOAD(i, k0) do { sr_[i].vs0 = *reinterpret_cast<const bf16x8*>(&Vh[(long)((k0) + sr) * LD + sc]); sr_[i].vs1 = *reinterpret_cast<const bf16x8*>(&Vh[(long)((k0) + 32 + sr) * LD + sc]); \
    sr_[i].ks0 = *reinterpret_cast<const bf16x8*>(&Kh[(long)((k0) + sr) * LD + sc]); sr_[i].ks1 = *reinterpret_cast<const bf16x8*>(&Kh[(long)((k0) + 32 + sr) * LD + sc]); } while (0)
#define SWRITE(b, i) do { *(bf16x8*)((char*)V_lds + (b) * SHM_V + vst0) = sr_[i].vs0;          \
    *(bf16x8*)((char*)V_lds + (b) * SHM_V + vst1) = sr_[i].vs1; int kc = sc * 2;               \
    *(bf16x8*)((char*)K_lds + (b) * SHM_K + KSWZ(sr, kc)) = sr_[i].ks0;                       \
    *(bf16x8*)((char*)K_lds + (b) * SHM_K + KSWZ(32 + sr, kc)) = sr_[i].ks1; } while (0)
#define SWAIT() asm volatile("s_waitcnt vmcnt(4)" ::: "memory")
#define RESC(a) do { if (__any((a) < 1.f)) { if (hi == 0) al_l[r32] = (a); asm volatile("s_waitcnt lgkmcnt(0)" ::: "memory"); \
    _Pragma("unroll") for (int d = 0; d < 4; ++d) _Pragma("unroll") for (int r = 0; r < 16; ++r) o[d][r] *= al_l[crow(r, hi)]; } } while (0)
  f32x16 pA0, pA1, pB0, pB1; float mnA, mnB, alA, alB; bf16x8 pa0, pa1, pa2, pa3; const int NT = seq / KVBLK;
  constexpr int SE = 0, SO = 1;
  SLOAD(SE, 0); asm volatile("s_waitcnt vmcnt(0)" ::: "memory"); SWRITE(0, SE); __syncthreads();
  qkt(pA0, pA1, K_lds, qr, r32, hi); partialSM(pA0, pA1, m_reg, mnA, alA);
  SLOAD(SO, KVBLK); if (2 < NT) SLOAD(SE, 2 * KVBLK);
  SWAIT(); SWRITE(1, SO); __syncthreads();
  for (int j = 1; j + 1 < NT; j += 2) {
    SBAR(); qkt(pB0, pB1, (bf16_t*)((char*)K_lds + SHM_K), qr, r32, hi);
    finishSM(pA0, pA1, alA, l_reg, pa0, pa1, pa2, pa3); SBAR();
    SLOAD(SO, (j + 2) * KVBLK); SBAR();
    pv_d0(o, vb0, pa0, pa1, pa2, pa3); partialSM(pB0, pB1, m_reg, mnB, alB);
    __syncthreads(); SWAIT(); SWRITE(0, SE);
    RESC(alB); __syncthreads();
    SBAR(); qkt(pA0, pA1, K_lds, qr, r32, hi);
    finishSM(pB0, pB1, alB, l_reg, pa0, pa1, pa2, pa3); SBAR();
    if (j + 3 < NT) SLOAD(SE, (j + 3) * KVBLK); SBAR();
    pv_d0(o, vb0 + (int)SHM_V, pa0, pa1, pa2, pa3); partialSM(pA0, pA1, m_reg, mnA, alA);
    __syncthreads(); SWAIT(); SWRITE(1, SO);
    RESC(alA); __syncthreads();
  }
  SBAR(); qkt(pB0, pB1, (bf16_t*)((char*)K_lds + SHM_K), qr, r32, hi);
  finishSM(pA0, pA1, alA, l_reg, pa0, pa1, pa2, pa3); SBAR();
  pv_d0(o, vb0, pa0, pa1, pa2, pa3); partialSM(pB0, pB1, m_reg, mnB, alB);
  __syncthreads(); RESC(alB);
  finishSM(pB0, pB1, alB, l_reg, pa0, pa1, pa2, pa3); SBAR();
  pv_d0(o, vb0 + (int)SHM_V, pa0, pa1, pa2, pa3);
  if (hi == 0) li_l[r32] = l_reg; asm volatile("s_waitcnt lgkmcnt(0)" ::: "memory");
  float rli[16];
#pragma unroll
  for (int r = 0; r < 16; ++r) rli[r] = __builtin_amdgcn_rcpf(li_l[crow(r, hi)]);
  bf16_t* Ow = Ob + (long)(wid * QBLK) * LD;
#pragma unroll
  for (int r = 0; r < 16; ++r) { int orow = crow(r, hi);
#pragma unroll
    for (int d0 = 0; d0 < 4; ++d0) Ow[(long)orow * LD + d0 * 32 + r32] = (bf16_t)f2bf(o[d0][r] * rli[r]); }
  __syncthreads();
#undef SLOAD
#undef SWRITE
#undef SWAIT
#undef RESC
}

__device__ __forceinline__ void attn_pair_body(const bf16_t* __restrict__ Qb, const bf16_t* __restrict__ Kh, const bf16_t* __restrict__ Vh, bf16_t* __restrict__ Ob, int seq, char* lds) {
  int tid_ = threadIdx.x; asm volatile("" : "+v"(tid_));
  const int tid = tid_, wid = __builtin_amdgcn_readfirstlane(tid >> 6), lane = tid & 63, r32 = lane & 31, hi = lane >> 5, ph = wid >> 2, pw = wid & 3;
  char* V_lds = lds; char* K_lds = lds + 65536;
  float* wsf = (float*)(lds + 98304) + wid * 128; float* li_l = wsf; float* al_l = wsf + 32; float* mx_l = wsf + 64;
  const float* pwsf = (const float*)(lds + 98304) + (wid ^ 4) * 128;
  u32x4* pex_own = (u32x4*)(lds + 102400) + wid * 128 + lane; const u32x4* pex_par = (const u32x4*)(lds + 102400) + (wid ^ 4) * 128 + lane;
  float m_reg = -1e30f, l_reg = 0; f32x16 o[4] = {}; bf16x8 qr[8];
  const bf16_t* Qw = Qb + (long)(pw * QBLK + r32) * LD + hi * 8;
#pragma unroll
  for (int d0 = 0; d0 < 8; ++d0) qr[d0] = *reinterpret_cast<const bf16x8*>(Qw + d0 * 16);
  const int sr = tid >> 4, sc = (tid & 15) * 8, vst0 = v_st(sr, sc), vst1 = v_st(32 + sr, sc);
  const int vb0 = (int)(uintptr_t)V_lds + ph * (int)SHM_V + v_rd_base(lane);
  const int krow = ph * 32 + r32;
  const int NT = seq / KVBLK;
  struct { bf16x8 k0, k1; } ks_[2]; struct { bf16x8 v00, v01, v10, v11; } vs_[2];
#define PLOADK(i, t) do { const long k0_ = (long)((t) < NT ? (t) : NT - 1) * KVBLK; \
    ks_[i].k0 = *reinterpret_cast<const bf16x8*>(&Kh[(k0_ + sr) * LD + sc]); ks_[i].k1 = *reinterpret_cast<const bf16x8*>(&Kh[(k0_ + 32 + sr) * LD + sc]); } while (0)
#define PLOADV(i, t) do { const long k0_ = (long)((t) < NT ? (t) : NT - 1) * KVBLK; \
    vs_[i].v00 = *reinterpret_cast<const bf16x8*>(&Vh[(k0_ + sr) * LD + sc]); vs_[i].v01 = *reinterpret_cast<const bf16x8*>(&Vh[(k0_ + 32 + sr) * LD + sc]); \
    vs_[i].v10 = *reinterpret_cast<const bf16x8*>(&Vh[(k0_ + sr) * LD + 128 + sc]); vs_[i].v11 = *reinterpret_cast<const bf16x8*>(&Vh[(k0_ + 32 + sr) * LD + 128 + sc]); } while (0)
#define PWRITEK(b, i) do { const int kc = sc * 2; *(bf16x8*)(K_lds + (b) * SHM_K + KSWZ(sr, kc)) = ks_[i].k0; *(bf16x8*)(K_lds + (b) * SHM_K + KSWZ(32 + sr, kc)) = ks_[i].k1; } while (0)
#define PWRITEV(b, i) do { *(bf16x8*)(V_lds + (b) * 2 * SHM_V + vst0) = vs_[i].v00; *(bf16x8*)(V_lds + (b) * 2 * SHM_V + vst1) = vs_[i].v01; \
    *(bf16x8*)(V_lds + (b) * 2 * SHM_V + SHM_V + vst0) = vs_[i].v10; *(bf16x8*)(V_lds + (b) * 2 * SHM_V + SHM_V + vst1) = vs_[i].v11; } while (0)
#define PK4(P, BASE, OUT) do { unsigned a0 = cvtpk(P[BASE + 0], P[BASE + 1]), a1 = cvtpk(P[BASE + 2], P[BASE + 3]);   \
    unsigned b0 = cvtpk(P[BASE + 4], P[BASE + 5]), b1 = cvtpk(P[BASE + 6], P[BASE + 7]);                              \
    auto r0 = __builtin_amdgcn_permlane32_swap(a0, b0, false, false); auto r1 = __builtin_amdgcn_permlane32_swap(a1, b1, false, false); \
    OUT = (u32x4){r0[0], r1[0], r0[1], r1[1]}; } while (0)
#define PQKT(P, b) do { bf16x8 kf[4]; P = f32x16{}; \
    _Pragma("unroll") for (int d0 = 0; d0 < 4; ++d0) kf[d0] = *reinterpret_cast<const bf16x8*>(K_lds + (b) * SHM_K + KSWZ(krow, (d0 * 16 + hi * 8) * 2)); \
    asm volatile("s_waitcnt lgkmcnt(0)" ::: "memory"); SBAR(); \
    _Pragma("unroll") for (int d0 = 0; d0 < 4; ++d0) P = __builtin_amdgcn_mfma_f32_32x32x16_bf16(kf[d0], qr[d0], P, 0, 0, 0); \
    SBAR(); \
    _Pragma("unroll") for (int d0 = 0; d0 < 4; ++d0) kf[d0] = *reinterpret_cast<const bf16x8*>(K_lds + (b) * SHM_K + KSWZ(krow, ((d0 + 4) * 16 + hi * 8) * 2)); \
    asm volatile("s_waitcnt lgkmcnt(0)" ::: "memory"); SBAR(); \
    _Pragma("unroll") for (int d0 = 0; d0 < 4; ++d0) P = __builtin_amdgcn_mfma_f32_32x32x16_bf16(kf[d0], qr[d0 + 4], P, 0, 0, 0); } while (0)
#define PROWMAX(P, PM) do { PM = P[0]; _Pragma("unroll") for (int r = 1; r < 16; ++r) PM = fmaxf(PM, P[r]); \
    { auto rr = __builtin_amdgcn_permlane32_swap(__float_as_uint(PM), __float_as_uint(PM), false, false); PM = fmaxf(__uint_as_float(rr[0]), __uint_as_float(rr[1])); } \
    if (hi == 0) mx_l[r32] = PM; } while (0)
#define PSTEP(B, j, PC, PMC, PN, PMN) do { constexpr float C = SCALE * 1.4426950408889634f; \
      \
    SBAR(); PQKT(PN, 1 - (B)); \
    float pmax = fmaxf(PMC, pwsf[64 + r32]); \
    float mn, alpha; \
    if (__builtin_expect(__all(pmax - m_reg <= THR / SCALE), 1)) { mn = m_reg; alpha = 1.f; } \
    else { mn = fmaxf(m_reg, pmax); alpha = __builtin_amdgcn_exp2f((m_reg - mn) * C); m_reg = mn; } \
    const float mnC = -mn * C; \
    _Pragma("unroll") for (int r = 0; r < 16; ++r) PC[r] = __builtin_amdgcn_exp2f(fmaf(PC[r], C, mnC)); \
    float ps = 0; _Pragma("unroll") for (int r = 0; r < 16; ++r) ps += PC[r]; \
    { auto rr = __builtin_amdgcn_permlane32_swap(__float_as_uint(ps), __float_as_uint(ps), false, false); ps = __uint_as_float(rr[0]) + __uint_as_float(rr[1]); } \
    l_reg = l_reg * alpha + ps; \
    u32x4 f0, f1; PK4(PC, 0, f0); PK4(PC, 8, f1); pex_own[0] = f0; pex_own[64] = f1; \
    const bool resc = __any(alpha < 1.f); if (resc && hi == 0) al_l[r32] = alpha; \
    asm volatile("s_waitcnt vmcnt(8)" ::: "memory"); PWRITEV(1 - (B), 1 - (B)); PLOADV(1 - (B), (j) + 3); \
    asm volatile("s_waitcnt lgkmcnt(0)" ::: "memory"); __syncthreads();              \
      \
    const u32x4 g0 = pex_par[0], g1 = pex_par[64]; \
    if (resc) { _Pragma("unroll") for (int d = 0; d < 4; ++d) _Pragma("unroll") for (int r = 0; r < 16; ++r) o[d][r] *= al_l[crow(r, hi)]; } \
    const u32x4 q0 = ph ? g0 : f0, q1 = ph ? g1 : f1, q2 = ph ? f0 : g0, q3 = ph ? f1 : g1; \
    SBAR(); pv_d0(o, vb0 + (B) * 2 * (int)SHM_V, __builtin_bit_cast(bf16x8, q0), __builtin_bit_cast(bf16x8, q1), __builtin_bit_cast(bf16x8, q2), __builtin_bit_cast(bf16x8, q3)); \
    asm volatile("s_waitcnt vmcnt(10)" ::: "memory"); PWRITEK(B, B); PLOADK(B, (j) + 4); \
    PROWMAX(PN, PMN); \
    asm volatile("s_waitcnt lgkmcnt(0)" ::: "memory"); __syncthreads();              \
  } while (0)
  f32x16 pA, pB; float pmA, pmB;
  PLOADK(0, 0); PLOADV(0, 0); PLOADK(1, 1); asm volatile("s_waitcnt vmcnt(0)" ::: "memory"); PWRITEK(0, 0); PWRITEV(0, 0); PWRITEK(1, 1);
  PLOADV(1, 1); PLOADK(0, 2); PLOADV(0, 2); PLOADK(1, 3);
  asm volatile("s_waitcnt lgkmcnt(0)" ::: "memory"); __syncthreads();
  PQKT(pA, 0); PROWMAX(pA, pmA); pB = f32x16{}; pmB = 0.f;
  asm volatile("s_waitcnt lgkmcnt(0)" ::: "memory"); __syncthreads();
#pragma unroll 1
  for (int j = 0; j < NT; j += 2) { PSTEP(0, j, pA, pmA, pB, pmB); PSTEP(1, j + 1, pB, pmB, pA, pmA); }
  if (hi == 0) li_l[r32] = l_reg; asm volatile("s_waitcnt lgkmcnt(0)" ::: "memory"); __syncthreads();
  float rli[16];
#pragma unroll
  for (int r = 0; r < 16; ++r) rli[r] = __builtin_amdgcn_rcpf(li_l[crow(r, hi)] + pwsf[crow(r, hi)]);
  bf16_t* Ow = Ob + (long)(pw * QBLK) * LD + ph * 128;
#pragma unroll
  for (int r = 0; r < 16; ++r) { int orow = crow(r, hi);
#pragma unroll
    for (int d0 = 0; d0 < 4; ++d0) Ow[(long)orow * LD + d0 * 32 + r32] = (bf16_t)f2bf(o[d0][r] * rli[r]); }
  __syncthreads();
#undef PLOADK
#undef PLOADV
#undef PWRITEK
#undef PWRITEV
#undef PK4
#undef PQKT
#undef PROWMAX
#undef PSTEP
}
}

namespace scan {
constexpr int PQ = 272, PT = 80;
constexpr int OFF_QH = 0, OFF_KT = 8704, OFF_KTT = 17408, OFF_VT = 27648, OFF_EBL = 37888, BUF = 38400;
static_assert(2 * BUF <= MISC_OFF, "scan LDS map");
constexpr float LOG2E = 1.4426950408889634f;
struct Ld { f32x2 lf[8]; unsigned q[8], k[8], v[8]; };
__device__ __forceinline__ int seq_row(int b, int dir, int s) { return b * TPB + (dir == 0 ? s : (s < CTXL ? (CTXL - 1 - s) : (TPB + CTXL - 1 - s))); }

__device__ __forceinline__ void scan_unit(LAS unsigned char* lds, const bf16_t* Q, const bf16_t* Kd, const _Float16* LFd, const bf16_t* V, bf16_t* Od, int b, int h, int dir) {
    int tid_ = threadIdx.x; asm volatile("" : "+v"(tid_));
    const int tid = tid_, lane = tid & 63, wv = __builtin_amdgcn_readfirstlane(tid >> 6);
    constexpr int NBLK = TPB / 32;
    const int rs_ = dir == 0 ? 2048 : -2048;
    if (wv >= 4) {
        const int dp = 16 * (wv - 4) + (lane & 15), tg = lane >> 4;
        Ld ra, rb;
#define SCAN_LOAD(R, blk) do { const long o0_ = (long)seq_row(b, dir, (blk) * 32 + 8 * tg) * 2048 + h * 128 + 2 * dp; \
        _Pragma("unroll") for (int i = 0; i < 8; ++i) { const long o_ = o0_ + (long)i * rs_; { typedef _Float16 h2 __attribute__((ext_vector_type(2))); const h2 l_ = *(const h2*)(LFd + o_); R.lf[i] = (f32x2){(float)l_[0], (float)l_[1]}; } R.q[i] = *(const unsigned*)(Q + o_); R.k[i] = *(const unsigned*)(Kd + o_); R.v[i] = *(const unsigned*)(V + o_); } } while (0)
#define SCAN_PREP(R, bufb) do { f32x2 cs[8]; cs[0] = R.lf[0]; _Pragma("unroll") for (int i = 1; i < 8; ++i) cs[i] = cs[i - 1] + R.lf[i]; \
        f32x2 pre = (f32x2){0.f, 0.f}, tot = (f32x2){0.f, 0.f}; \
        _Pragma("unroll") for (int g = 0; g < 4; ++g) { f32x2 t_; t_.x = __shfl(cs[7].x, (lane & 15) + 16 * g); t_.y = __shfl(cs[7].y, (lane & 15) + 16 * g); tot += t_; if (g < tg) pre += t_; } \
        unsigned ktp[8]; \
        _Pragma("unroll") for (int i = 0; i < 8; ++i) { const int tk = 8 * tg + i; const f32x2 bc = (pre + cs[i]) * LOG2E; \
            const float e0 = __builtin_amdgcn_exp2f(bc.x), e1 = __builtin_amdgcn_exp2f(bc.y), i0 = __builtin_amdgcn_exp2f(-bc.x), i1 = __builtin_amdgcn_exp2f(-bc.y); \
            *(LAS unsigned*)((bufb) + OFF_QH + tk * PQ + dp * 4) = cvt_pk_bf16(bf2f(R.q[i] & 0xffffu) * e0, bf2f(R.q[i] >> 16) * e1); \
            ktp[i] = cvt_pk_bf16(bf2f(R.k[i] & 0xffffu) * i0, bf2f(R.k[i] >> 16) * i1); \
            *(LAS unsigned*)((bufb) + OFF_KT + tk * PQ + dp * 4) = ktp[i]; } \
        u32x4 w_; \
        w_.x = (ktp[0] & 0xffffu) | (ktp[1] << 16); w_.y = (ktp[2] & 0xffffu) | (ktp[3] << 16); w_.z = (ktp[4] & 0xffffu) | (ktp[5] << 16); w_.w = (ktp[6] & 0xffffu) | (ktp[7] << 16); *(LAS u32x4*)((bufb) + OFF_KTT + (2 * dp) * PT + tg * 16) = w_; \
        w_.x = (ktp[0] >> 16) | (ktp[1] & 0xffff0000u); w_.y = (ktp[2] >> 16) | (ktp[3] & 0xffff0000u); w_.z = (ktp[4] >> 16) | (ktp[5] & 0xffff0000u); w_.w = (ktp[6] >> 16) | (ktp[7] & 0xffff0000u); *(LAS u32x4*)((bufb) + OFF_KTT + (2 * dp + 1) * PT + tg * 16) = w_; \
        w_.x = (R.v[0] & 0xffffu) | (R.v[1] << 16); w_.y = (R.v[2] & 0xffffu) | (R.v[3] << 16); w_.z = (R.v[4] & 0xffffu) | (R.v[5] << 16); w_.w = (R.v[6] & 0xffffu) | (R.v[7] << 16); *(LAS u32x4*)((bufb) + OFF_VT + (2 * dp) * PT + tg * 16) = w_; \
        w_.x = (R.v[0] >> 16) | (R.v[1] & 0xffff0000u); w_.y = (R.v[2] >> 16) | (R.v[3] & 0xffff0000u); w_.z = (R.v[4] >> 16) | (R.v[5] & 0xffff0000u); w_.w = (R.v[6] >> 16) | (R.v[7] & 0xffff0000u); *(LAS u32x4*)((bufb) + OFF_VT + (2 * dp + 1) * PT + tg * 16) = w_; \
        if (tg == 0) *(LAS f32x2*)((bufb) + OFF_EBL + dp * 8) = (f32x2){__builtin_amdgcn_exp2f(tot.x * LOG2E), __builtin_amdgcn_exp2f(tot.y * LOG2E)}; } while (0)
        SCAN_LOAD(ra, 0); SCAN_LOAD(rb, 1);
        SCAN_PREP(ra, lds); SCAN_LOAD(ra, 2);
        LDS_WAIT(); __syncthreads();
        for (int n = 0; n < NBLK; n += 2) {
            if (n + 1 < NBLK) { SCAN_PREP(rb, lds + BUF); } SCAN_LOAD(rb, (n + 3 < NBLK ? n + 3 : NBLK - 1));
            LDS_WAIT(); __syncthreads();
            if (n + 2 < NBLK) { SCAN_PREP(ra, lds); } SCAN_LOAD(ra, (n + 4 < NBLK ? n + 4 : NBLK - 1));
            LDS_WAIT(); __syncthreads();
        }
#undef SCAN_LOAD
#undef SCAN_PREP
    } else {
        const int c16 = lane & 15, q4 = lane >> 4;
        f32x4 S[2][8];
#pragma unroll
        for (int ct = 0; ct < 2; ++ct)
#pragma unroll
            for (int t = 0; t < 8; ++t) S[ct][t] = (f32x4){0.f, 0.f, 0.f, 0.f};
        __syncthreads();
#pragma unroll 1
        for (int n = 0; n < NBLK; ++n) {
            LAS unsigned char* bc_ = lds + (n & 1) * BUF;
            f32x4 c00 = (f32x4){0.f, 0.f, 0.f, 0.f}, c01 = c00, c11 = c00;
#pragma unroll
            for (int ks = 0; ks < 4; ++ks) {
                const bf16x8 k0 = *(const LAS bf16x8*)(bc_ + OFF_KT + c16 * PQ + (32 * ks + 8 * q4) * 2), k1 = *(const LAS bf16x8*)(bc_ + OFF_KT + (16 + c16) * PQ + (32 * ks + 8 * q4) * 2);
                const bf16x8 q0 = *(const LAS bf16x8*)(bc_ + OFF_QH + c16 * PQ + (32 * ks + 8 * q4) * 2), q1 = *(const LAS bf16x8*)(bc_ + OFF_QH + (16 + c16) * PQ + (32 * ks + 8 * q4) * 2);
                c00 = __builtin_amdgcn_mfma_f32_16x16x32_bf16(k0, q0, c00, 0, 0, 0); c01 = __builtin_amdgcn_mfma_f32_16x16x32_bf16(k0, q1, c01, 0, 0, 0); c11 = __builtin_amdgcn_mfma_f32_16x16x32_bf16(k1, q1, c11, 0, 0, 0); }
#pragma unroll
            for (int r = 0; r < 4; ++r) if (4 * q4 + r > c16) { c00[r] = 0.f; c11[r] = 0.f; }
            u32x4 a0w, a1w; a0w.x = cvt_pk_bf16(c00[0], c00[1]); a0w.y = cvt_pk_bf16(c00[2], c00[3]); a0w.z = 0u; a0w.w = 0u;
            a1w.x = cvt_pk_bf16(c01[0], c01[1]); a1w.y = cvt_pk_bf16(c01[2], c01[3]); a1w.z = cvt_pk_bf16(c11[0], c11[1]); a1w.w = cvt_pk_bf16(c11[2], c11[3]);
            f32x4 o0[2], o1[2];
#pragma unroll
            for (int ct = 0; ct < 2; ++ct) { const int dv = 32 * wv + 16 * ct + c16;
                u32x4 bvw; { const u32x2 lo = *(const LAS u32x2*)(bc_ + OFF_VT + dv * PT + (4 * q4) * 2), hi_ = *(const LAS u32x2*)(bc_ + OFF_VT + dv * PT + (16 + 4 * q4) * 2); bvw.x = lo.x; bvw.y = lo.y; bvw.z = hi_.x; bvw.w = hi_.y; }
                o0[ct] = __builtin_amdgcn_mfma_f32_16x16x32_bf16(__builtin_bit_cast(bf16x8, a0w), __builtin_bit_cast(bf16x8, bvw), (f32x4){0.f, 0.f, 0.f, 0.f}, 0, 0, 0);
                o1[ct] = __builtin_amdgcn_mfma_f32_16x16x32_bf16(__builtin_bit_cast(bf16x8, a1w), __builtin_bit_cast(bf16x8, bvw), (f32x4){0.f, 0.f, 0.f, 0.f}, 0, 0, 0); }
#pragma unroll
            for (int ks = 0; ks < 4; ++ks) {
                u32x4 q0w, q1w; { const u32x2 l0 = *(const LAS u32x2*)(bc_ + OFF_QH + c16 * PQ + (32 * ks + 4 * q4) * 2), h0 = *(const LAS u32x2*)(bc_ + OFF_QH + c16 * PQ + (32 * ks + 16 + 4 * q4) * 2);
                    const u32x2 l1 = *(const LAS u32x2*)(bc_ + OFF_QH + (16 + c16) * PQ + (32 * ks + 4 * q4) * 2), h1 = *(const LAS u32x2*)(bc_ + OFF_QH + (16 + c16) * PQ + (32 * ks + 16 + 4 * q4) * 2);
                    q0w.x = l0.x; q0w.y = l0.y; q0w.z = h0.x; q0w.w = h0.y; q1w.x = l1.x; q1w.y = l1.y; q1w.z = h1.x; q1w.w = h1.y; }
#pragma unroll
                for (int ct = 0; ct < 2; ++ct) {
                    u32x4 sw; sw.x = cvt_pk_bf16(S[ct][2 * ks][0], S[ct][2 * ks][1]); sw.y = cvt_pk_bf16(S[ct][2 * ks][2], S[ct][2 * ks][3]); sw.z = cvt_pk_bf16(S[ct][2 * ks + 1][0], S[ct][2 * ks + 1][1]); sw.w = cvt_pk_bf16(S[ct][2 * ks + 1][2], S[ct][2 * ks + 1][3]);
                    o0[ct] = __builtin_amdgcn_mfma_f32_16x16x32_bf16(__builtin_bit_cast(bf16x8, q0w), __builtin_bit_cast(bf16x8, sw), o0[ct], 0, 0, 0);
                    o1[ct] = __builtin_amdgcn_mfma_f32_16x16x32_bf16(__builtin_bit_cast(bf16x8, q1w), __builtin_bit_cast(bf16x8, sw), o1[ct], 0, 0, 0); } }
#pragma unroll
            for (int ct = 0; ct < 2; ++ct) { bf16_t* op_ = Od + (size_t)seq_row(b, dir, n * 32 + 4 * q4) * 2048 + h * 128 + 32 * wv + 16 * ct + c16;
#pragma unroll
                for (int r = 0; r < 4; ++r) { op_[(long)r * rs_] = (bf16_t)f2bf(o0[ct][r]); op_[(long)(16 + r) * rs_] = (bf16_t)f2bf(o1[ct][r]); } }
            { bf16x8 bv2[2];
#pragma unroll
              for (int ct = 0; ct < 2; ++ct) bv2[ct] = *(const LAS bf16x8*)(bc_ + OFF_VT + (32 * wv + 16 * ct + c16) * PT + q4 * 16);
#pragma unroll
              for (int t = 0; t < 8; ++t) { const bf16x8 ak = *(const LAS bf16x8*)(bc_ + OFF_KTT + (16 * t + c16) * PT + q4 * 16);
                  S[0][t] = __builtin_amdgcn_mfma_f32_16x16x32_bf16(ak, bv2[0], S[0][t], 0, 0, 0); S[1][t] = __builtin_amdgcn_mfma_f32_16x16x32_bf16(ak, bv2[1], S[1][t], 0, 0, 0); }
#pragma unroll
              for (int t = 0; t < 8; ++t) { const f32x4 e = *(const LAS f32x4*)(bc_ + OFF_EBL + (16 * t + 4 * q4) * 4); S[0][t] *= e; S[1][t] *= e; } }
            LDS_WAIT(); __syncthreads();
        }
    }
}
}

struct Args { const float* in[18]; float* out; unsigned char* ws; int ph_lo, ph_hi; };

struct Frame {
    LAS unsigned char* lds; unsigned char* ws; const float* const* in;
    int tid, lane, wave, G, bx, vcu;
};

template <bool ROPE_PERM>
__device__ __forceinline__ void transpose_item(const float* W, int K, int N, bf16_t* WT, LAS float* scr, int item, int lane) {
    const int nblk = N / 32, kb = item / nblk, nb = item % nblk, k0 = 64 * kb, n0 = 32 * nb;
#pragma unroll 8
    for (int i = 0; i < 32; ++i) { const int kk = 2 * i + (lane >> 5); scr[kk * 33 + (lane & 31)] = W[(size_t)(k0 + kk) * N + n0 + (lane & 31)]; }
    LDS_WAIT(); asm volatile("" ::: "memory");
    const int c = lane & 7;
#pragma unroll
    for (int j = 0; j < 4; ++j) { const int n = (lane >> 3) + 8 * j; const LAS float* s = scr + (8 * c) * 33 + n;
        u32x4 o; o.x = f2bf(s[0 * 33]) | (f2bf(s[1 * 33]) << 16); o.y = f2bf(s[2 * 33]) | (f2bf(s[3 * 33]) << 16); o.z = f2bf(s[4 * 33]) | (f2bf(s[5 * 33]) << 16); o.w = f2bf(s[6 * 33]) | (f2bf(s[7 * 33]) << 16);
        int nn = n0 + n;
        if (ROPE_PERM) { if (nn < 4096) { const int d = nn & 127, base = nn - d; nn = base + (d < 64 ? 2 * d : 2 * (d - 64) + 1); } }
        *(GAS u32x4*)(WT + (size_t)nn * K + k0 + 8 * c) = o; }
    LDS_WAIT(); asm volatile("" ::: "memory");
}

#define FRAME_OPAQUE(F) do { int t_ = threadIdx.x; asm volatile("" : "+v"(t_)); (F).tid = t_; (F).lane = t_ & 63; } while (0)
__device__ __forceinline__ void p0_prologue(Frame& F) {
    FRAME_OPAQUE(F);
    const float* const* in = F.in; unsigned char* ws = F.ws;
    {
        LAS float* scr = (LAS float*)(F.lds + F.wave * 16384);
        const int gw = F.bx * NWAVES + F.wave, NGW = F.G * NWAVES;
        constexpr int I_W1 = (DM / 64) * (HID / 32), I_W2 = (HID / 64) * (DM / 32), I_SQ = (DM / 64) * (DM / 32), I_HIN = (DM / 64) * (10240 / 32), I_QKV = (DM / 64) * (6144 / 32);
        constexpr int NIT = 4 * I_W1 + 4 * I_W2 + 4 * I_SQ + I_HIN + I_QKV;
        for (int it = gw; it < NIT; it += NGW) {
            int r = it;
            if (r < 4 * I_W1) { const int l = r / I_W1; transpose_item<false>(in[7] + (size_t)l * DM * HID, DM, HID, (bf16_t*)(ws + WS_W1T) + (size_t)l * DM * HID, scr, r % I_W1, F.lane); continue; } r -= 4 * I_W1;
            if (r < 4 * I_W2) { const int l = r / I_W2; transpose_item<false>(in[8] + (size_t)l * DM * HID, HID, DM, (bf16_t*)(ws + WS_W2T) + (size_t)l * DM * HID, scr, r % I_W2, F.lane); continue; } r -= 4 * I_W2;
            if (r < 2 * I_SQ) { const int l = r / I_SQ; transpose_item<false>(in[9] + (size_t)l * DM * DM, DM, DM, (bf16_t*)(ws + WS_FWO) + (size_t)l * DM * DM, scr, r % I_SQ, F.lane); continue; } r -= 2 * I_SQ;
            if (r < I_SQ) { transpose_item<false>(in[13], DM, DM, (bf16_t*)(ws + WS_HWO), scr, r, F.lane); continue; } r -= I_SQ;
            if (r < I_SQ) { transpose_item<false>(in[17], DM, DM, (bf16_t*)(ws + WS_DWO), scr, r, F.lane); continue; } r -= I_SQ;
            if (r < I_HIN) { transpose_item<false>(in[10], DM, 10240, (bf16_t*)(ws + WS_HWIN), scr, r, F.lane); continue; } r -= I_HIN;
            transpose_item<true>(in[14], DM, 6144, (bf16_t*)(ws + WS_DQKV), scr, r, F.lane);
        }
    }
    __syncthreads();
    {
        const size_t gt = (size_t)F.bx * NTHR + F.tid, NT_ = (size_t)F.G * NTHR;
        bf16_t* CS = (bf16_t*)(ws + WS_CS);
        for (size_t e = gt; e < (size_t)2048 * 2048 / 2; e += NT_) {
            const int r = (int)(e / 1024), l = (int)(e % 1024) * 2; const int rr = r & 1023;
            const float x0 = (float)((rr * l) & 2047) * (1.f / 2048.f), x1 = (float)((rr * (l + 1)) & 2047) * (1.f / 2048.f);
            float v0 = r < 1024 ? __builtin_amdgcn_cosf(x0) : __builtin_amdgcn_sinf(x0), v1 = r < 1024 ? __builtin_amdgcn_cosf(x1) : __builtin_amdgcn_sinf(x1);
            if (r == 1024) { v0 = 1.f; v1 = -1.f; }
            *(unsigned*)(CS + (size_t)r * 2048 + l) = cvt_pk_bf16(v0, v1);
        }
        bf16_t* C2 = (bf16_t*)(ws + WS_CS256);
        for (size_t e = gt; e < (size_t)512 * 256 / 2; e += NT_) {
            const int r = (int)(e / 128), l = (int)(e % 128) * 2; const int rr = r & 255;
            const float x0 = (float)((rr * l) & 255) * (1.f / 256.f), x1 = (float)((rr * (l + 1)) & 255) * (1.f / 256.f);
            const float v0 = r < 256 ? __builtin_amdgcn_cosf(x0) : __builtin_amdgcn_sinf(x0), v1 = r < 256 ? __builtin_amdgcn_cosf(x1) : __builtin_amdgcn_sinf(x1);
            *(unsigned*)(C2 + (size_t)r * 2048 + l) = cvt_pk_bf16(v0, v1);
        }
        bf16_t* CC = (bf16_t*)(ws + WS_CC);
        for (size_t e = gt; e < (size_t)1024 * 512 / 2; e += NT_) {
            const int j = (int)(e / 256), k = (int)(e % 256) * 2; const int kk = k & 255, cp = j & 255;
            const float x0 = (float)((cp * kk) & 255) * (1.f / 256.f), x1 = (float)((cp * (kk + 1)) & 255) * (1.f / 256.f);
            float v0, v1;
            if (j < 512) { const float sg = j < 256 ? -1.f : 1.f; v0 = k < 256 ? __builtin_amdgcn_cosf(x0) : sg * __builtin_amdgcn_sinf(x0); v1 = k < 256 ? __builtin_amdgcn_cosf(x1) : sg * __builtin_amdgcn_sinf(x1); }
            else { const bool on = ((j - 512) < 256) == (k < 256); v0 = on ? __builtin_amdgcn_cosf(x0) : 0.f; v1 = on ? __builtin_amdgcn_cosf(x1) : 0.f; }
            *(unsigned*)(CC + (size_t)j * 512 + k) = cvt_pk_bf16(v0, v1);
        }
        float* rc = (float*)(ws + WS_ROPE); float* rs = rc + 2048 * 64;
        for (size_t e = gt; e < (size_t)2048 * 64; e += NT_) {
            const int pos = (int)(e >> 6), i = (int)(e & 63);
            const float inv = powf(10000.f, -(float)(i & 31) / 32.f);
            const float ang = (float)(i < 32 ? (pos >> 6) : (pos & 63)) * inv;
            rc[e] = cosf(ang); rs[e] = sinf(ang);
        }
        float* lb = (float*)(ws + WS_LB); const float* p = in[11];
        for (size_t e = gt; e < (size_t)2 * 2048; e += NT_) {
            const float a0 = p[e], a1 = p[4096 + e], a2 = p[8192 + e], a3 = p[12288 + e];
            const float mx = fmaxf(fmaxf(a0, a1), fmaxf(a2, a3));
            const float e0 = expf(a0 - mx), e1 = expf(a1 - mx), e2 = expf(a2 - mx), e3 = expf(a3 - mx);
            lb[e] = e1 / (e0 + e1 + e2 + e3);
        }
    }
    {
        LAS float* sS = (LAS float*)F.lds;
        for (int e = F.tid; e < 2048; e += NTHR) {
#pragma unroll
            for (int r = 0; r < 5; ++r) { const float c = r < 4 ? in[1][r * 2048 + e] : in[3][e]; sS[e * 8 + r] = c / (1.f + __expf(-c)); }
        }
        LDS_WAIT(); __syncthreads();
        for (int cb = F.bx; cb < 256; cb += F.G) {
            const int col0 = cb * 192;
            const int layer = col0 / 12288, n0 = col0 % 12288;
            const float* W = in[4] + (size_t)layer * DM * 12288 + n0;
            f32x4 a[5];
#pragma unroll
            for (int r = 0; r < 5; ++r) a[r] = (f32x4){0.f, 0.f, 0.f, 0.f};
            if (F.lane < 48) {
                const int kb = F.wave * 256;
#pragma unroll 16
                for (int k = 0; k < 256; ++k) {
                    const f32x4 w = __builtin_nontemporal_load((const f32x4*)(W + (size_t)(kb + k) * 12288 + 4 * F.lane));
                    const f32x4 s4 = *(const LAS f32x4*)(sS + (kb + k) * 8); const float s5 = sS[(kb + k) * 8 + 4];
                    a[0] += w * s4[0]; a[1] += w * s4[1]; a[2] += w * s4[2]; a[3] += w * s4[3]; a[4] += w * s5;
                }
            }
            __syncthreads();
            LAS float* red = (LAS float*)(F.lds + 65536);
            if (F.lane < 48) {
#pragma unroll
                for (int r = 0; r < 5; ++r) *(LAS f32x4*)(red + (F.wave * 5 + r) * 192 + 4 * F.lane) = a[r];
            }
            LDS_WAIT(); __syncthreads();
            float* MOD = (float*)(ws + WS_MOD);
            for (int e = F.tid; e < 5 * 192; e += NTHR) { const int r = e / 192, n = e % 192; float s = 0.f;
#pragma unroll
                for (int w8 = 0; w8 < 8; ++w8) s += red[(w8 * 5 + r) * 192 + n];
                MOD[((size_t)layer * 5 + r) * 12288 + n0 + n] = s + in[5][layer * 12288 + n0 + n]; }
        }
        __syncthreads();
    }
}

__device__ __forceinline__ int mod_row(int row) { const int b = row / TPB; return (row - b * TPB) < CTXL ? 4 : b; }
__device__ __forceinline__ float sumsq8(const f32x4 (&v)[8]) { float s = 0.f;
#pragma unroll
    for (int j = 0; j < 8; ++j) s += (v[j][0] * v[j][0] + v[j][1] * v[j][1]) + (v[j][2] * v[j][2] + v[j][3] * v[j][3]);
    return wave_sum(s); }

__device__ __forceinline__ void norm_mod(const f32x4 (&x)[8], const float* g, const float* sh, const float* sc, int lane, u32x2 (&hp)[8]) {
    const float rs = rsqrtf(sumsq8(x) * (1.f / DM) + NORM_EPS);
#pragma unroll
    for (int j = 0; j < 8; ++j) { const int c = 4 * lane + 256 * j; const f32x4 gv = *(const f32x4*)(g + c), shv = *(const f32x4*)(sh + c), scv = *(const f32x4*)(sc + c);
        const f32x4 hv = (x[j] * rs) * gv * (scv + 1.f) + shv; hp[j].x = cvt_pk_bf16(hv[0], hv[1]); hp[j].y = cvt_pk_bf16(hv[2], hv[3]); }
}
template <int MODE>
__device__ __forceinline__ void row_phase(Frame& F, int layer, bool latonly, bool tr, float* dout, bool splitk) {
    FRAME_OPAQUE(F);
    unsigned char* ws = F.ws; const float* const* in = F.in;
    typedef _Float16 h4 __attribute__((ext_vector_type(4)));
    _Float16* X = (_Float16*)(ws + WS_X); const bf16_t* YO = (const bf16_t*)(ws + WS_YO); bf16_t* H = (bf16_t*)(ws + WS_H);
    const float* MOD = (const float*)(ws + WS_MOD); const float* ng = in[6];
    const int nextl = MODE == 2 ? layer + 1 : layer;
    const int nlat = NBATCH * SEQ / 32;
    const bool deal_ctx = !latonly && !tr, ctx2 = !latonly && tr;
    LAS unsigned* T = (LAS unsigned*)F.lds;
    for (int it = F.bx; it < nlat; it += F.G) {
        const int ib = it / (SEQ / 32), ip0 = (it % (SEQ / 32)) * 32;
        LAS f32x4* VL = (LAS f32x4*)F.lds;
        if (!tr) {
            __syncthreads();
            const float* gg_ = ng + (layer * 4 + (MODE == 1 ? 1 : 3)) * DM; const float* g2_ = ng + ((nextl < DEPTH ? nextl : 0) * 4 + (MODE == 1 ? 2 : 0)) * DM;
            const float* m0_ = MOD + ((size_t)layer * 5 + ib) * 12288; const float* m1_ = MOD + ((size_t)(nextl < DEPTH ? nextl : 0) * 5 + ib) * 12288;
            const float* c0_ = MOD + ((size_t)layer * 5 + 4) * 12288; const float* c1_ = MOD + ((size_t)(nextl < DEPTH ? nextl : 0) * 5 + 4) * 12288;
            const int t4 = 4 * F.tid;
            if (MODE != 0) { VL[F.tid] = *(const f32x4*)(gg_ + t4); VL[2 * 512 + F.tid] = *(const f32x4*)(m0_ + (MODE == 1 ? 2 : 5) * DM + t4); VL[5 * 512 + F.tid] = *(const f32x4*)(c0_ + (MODE == 1 ? 2 : 5) * DM + t4); }
            VL[512 + F.tid] = *(const f32x4*)(g2_ + t4);
            VL[3 * 512 + F.tid] = *(const f32x4*)(m1_ + (MODE == 1 ? 3 : 0) * DM + t4); VL[4 * 512 + F.tid] = *(const f32x4*)(m1_ + (MODE == 1 ? 4 : 1) * DM + t4);
            VL[6 * 512 + F.tid] = *(const f32x4*)(c1_ + (MODE == 1 ? 3 : 0) * DM + t4); VL[7 * 512 + F.tid] = *(const f32x4*)(c1_ + (MODE == 1 ? 4 : 1) * DM + t4);
            LDS_WAIT(); __syncthreads();
        }
#pragma unroll 1
      for (int pass = 0; pass < (ctx2 ? 2 : 1); ++pass) {
        const int q0 = pass ? 4 : 0, nq = pass ? (F.wave < 4 ? 5 : 4) : 4 + ((deal_ctx && F.wave < 4) ? 1 : 0);
        u32x2 ybn[8]; h4 xvn[8];
        if (MODE != 0 && q0 == 0) { const size_t r0_ = (size_t)(ib * TPB + CTXL + ip0 + F.wave * 4) * DM + 4 * F.lane;
#pragma unroll
            for (int j = 0; j < 8; ++j) { ybn[j] = *(const u32x2*)(YO + r0_ + 256 * j); xvn[j] = *(const h4*)(X + r0_ + 256 * j); } }
#pragma unroll 1
        for (int q = q0; q < nq; ++q) {
            int b = ib, isctx = 0, pos = ip0 + F.wave * 4 + q;
            const int rl = pass ? F.wave : F.wave * 4 + q;
            if (q == 4) { const int cr = 4 * it + F.wave; b = cr / CTXL; pos = cr % CTXL; isctx = 1; }
            const int row = b * TPB + (isctx ? 0 : CTXL) + pos;
            const int mr = isctx ? 4 : b;
            f32x4 x[8];
            if (MODE == 0) {
                const float* src = isctx ? in[2] + ((size_t)b * CTXL + pos) * DM : in[0] + ((size_t)b * SEQ + pos) * DM;
#pragma unroll
                for (int j = 0; j < 8; ++j) x[j] = *(const f32x4*)(src + 4 * F.lane + 256 * j);
            } else {
                f32x4 y[8], xc[8];
                if (q < 4) {
#pragma unroll
                    for (int j = 0; j < 8; ++j) { y[j] = (f32x4){bf2f(ybn[j].x & 0xffffu), bf2f(ybn[j].x >> 16), bf2f(ybn[j].y & 0xffffu), bf2f(ybn[j].y >> 16)}; xc[j] = __builtin_convertvector(xvn[j], f32x4); }
                    { const size_t r1_ = (size_t)(q + 1 < 4 ? row + 1 : row) * DM + 4 * F.lane;
#pragma unroll
                        for (int j = 0; j < 8; ++j) { ybn[j] = *(const u32x2*)(YO + r1_ + 256 * j); xvn[j] = *(const h4*)(X + r1_ + 256 * j); } }
                } else {
#pragma unroll
                    for (int j = 0; j < 8; ++j) xc[j] = __builtin_convertvector(*(const h4*)(X + (size_t)row * DM + 4 * F.lane + 256 * j), f32x4);
                if (splitk && isctx) {
                    const bf16_t* sl = (const bf16_t*)(ws + WS_SLAB) + ((size_t)b * CTXL + pos) * DM + 4 * F.lane;
#pragma unroll
                    for (int j = 0; j < 8; ++j) y[j] = (f32x4){0.f, 0.f, 0.f, 0.f};
#pragma unroll 2
                    for (int k = 0; k < 8; ++k) {
#pragma unroll
                        for (int j = 0; j < 8; ++j) { const u32x2 yb = *(const u32x2*)(sl + 256 * j); y[j] += (f32x4){bf2f(yb.x & 0xffffu), bf2f(yb.x >> 16), bf2f(yb.y & 0xffffu), bf2f(yb.y >> 16)}; }
                        sl += SLAB_BYTES / 2; }
                } else {
#pragma unroll
                    for (int j = 0; j < 8; ++j) { const u32x2 yb = *(const u32x2*)(YO + (size_t)row * DM + 4 * F.lane + 256 * j);
                        y[j] = (f32x4){bf2f(yb.x & 0xffffu), bf2f(yb.x >> 16), bf2f(yb.y & 0xffffu), bf2f(yb.y >> 16)}; }
                }
                }
                const float rs = rsqrtf(sumsq8(y) * (1.f / DM) + NORM_EPS);
                const float* gg = ng + (layer * 4 + (MODE == 1 ? 1 : 3)) * DM; const float* gate = MOD + ((size_t)layer * 5 + mr) * 12288 + (MODE == 1 ? 2 : 5) * DM;
#pragma unroll
                for (int j = 0; j < 8; ++j) { const int c = 4 * F.lane + 256 * j; const f32x4 xv = xc[j];
                    const f32x4 gv = tr ? *(const f32x4*)(gg + c) : VL[F.lane + 64 * j], gt = tr ? *(const f32x4*)(gate + c) : VL[(isctx ? 5 : 2) * 512 + F.lane + 64 * j];
                    x[j] = xv + gt * ((y[j] * rs) * gv); }
            }
            if (dout) {
                float* o = dout + ((size_t)b * SEQ + pos) * DM;
#pragma unroll
                for (int j = 0; j < 8; ++j) *(f32x4*)(o + 4 * F.lane + 256 * j) = x[j];
            } else {
#pragma unroll
                for (int j = 0; j < 8; ++j) *(h4*)(X + (size_t)row * DM + 4 * F.lane + 256 * j) = __builtin_convertvector(x[j], h4);
                const float* g2 = ng + (nextl * 4 + (MODE == 1 ? 2 : 0)) * DM;
                const float* sh = MOD + ((size_t)nextl * 5 + mr) * 12288 + (MODE == 1 ? 3 : 0) * DM; const float* sc = sh + DM;
                u32x2 hp[8];
                if (tr) norm_mod(x, g2, sh, sc, F.lane, hp);
                else { const float rs2 = rsqrtf(sumsq8(x) * (1.f / DM) + NORM_EPS); const int so = (isctx ? 6 : 3) * 512;
#pragma unroll
                    for (int j = 0; j < 8; ++j) { const f32x4 gv = VL[512 + F.lane + 64 * j], shv = VL[so + F.lane + 64 * j], scv = VL[so + 512 + F.lane + 64 * j];
                        const f32x4 hv = (x[j] * rs2) * gv * (scv + 1.f) + shv; hp[j].x = cvt_pk_bf16(hv[0], hv[1]); hp[j].y = cvt_pk_bf16(hv[2], hv[3]); } }
                if (!tr) {
#pragma unroll
                    for (int j = 0; j < 8; ++j) *(u32x2*)(H + (size_t)row * DM + 4 * F.lane + 256 * j) = hp[j];
                } else {
#pragma unroll
                    for (int j = 0; j < 8; ++j) { T[rl * 1025 + 2 * F.lane + 128 * j] = hp[j].x; T[rl * 1025 + 2 * F.lane + 128 * j + 1] = hp[j].y; }
                }
            }
        }
        if (tr) {
            LDS_WAIT(); __syncthreads();
            if (pass == 0) {
                bf16_t* HT = (bf16_t*)(ws + SC_HT) + (size_t)ib * 2048 * 2048 + ip0;
                for (int e = F.tid; e < 16 * 1024; e += NTHR) { const int p2 = e & 15, cp = e >> 4;
                    const unsigned a = T[(2 * p2) * 1025 + cp], c = T[(2 * p2 + 1) * 1025 + cp];
                    const unsigned lo = (a & 0xffffu) | (c << 16), hi = (a >> 16) | (c & 0xffff0000u);
                    *(unsigned*)(HT + (size_t)(2 * cp) * 2048 + 2 * p2) = lo; *(unsigned*)(HT + (size_t)(2 * cp + 1) * 2048 + 2 * p2) = hi; }
            } else {
                const int cr0 = 4 * it; bf16_t* HT = (bf16_t*)(ws + SC_HTC) + (size_t)(cr0 / CTXL) * 2048 * 2048 + (cr0 % CTXL);
                for (int cp = F.tid; cp < 1024; cp += NTHR) { const unsigned a0 = T[cp], a1 = T[1025 + cp], a2 = T[2 * 1025 + cp], a3 = T[3 * 1025 + cp];
                    u32x2 lo, hi; lo.x = (a0 & 0xffffu) | (a1 << 16); lo.y = (a2 & 0xffffu) | (a3 << 16); hi.x = (a0 >> 16) | (a1 & 0xffff0000u); hi.y = (a2 >> 16) | (a3 & 0xffff0000u);
                    *(u32x2*)(HT + (size_t)(2 * cp) * 2048) = lo; *(u32x2*)(HT + (size_t)(2 * cp + 1) * 2048) = hi; }
            }
            LDS_WAIT(); __syncthreads();
        }
      }
    }
}

__device__ __forceinline__ void hgrn_readout_phase(Frame& F) {
    FRAME_OPAQUE(F);
    unsigned char* ws = F.ws; const float* gn = F.in[12];
    const bf16_t* O0 = (const bf16_t*)(ws + SC_HO); const bf16_t* O1 = O0 + ACT_ELEMS; const bf16_t* Gs = (const bf16_t*)(ws + SC_HG); bf16_t* Y = (bf16_t*)(ws + WS_ACT);
    const int gw = F.bx * NWAVES + F.wave, NGW = F.G * NWAVES;
    const f32x4 g = *(const f32x4*)(gn + ((4 * F.lane) & 127));
    u32x2 a0n[8], a1n[8], gsn[8];
    if (gw < NROW) {
#pragma unroll
        for (int j = 0; j < 8; ++j) { const size_t off = (size_t)gw * DM + 4 * F.lane + 256 * j; a0n[j] = *(const u32x2*)(O0 + off); a1n[j] = *(const u32x2*)(O1 + off); gsn[j] = *(const u32x2*)(Gs + off); } }
    for (int row = gw; row < NROW; row += NGW) {
        u32x2 a0[8], a1[8], gs[8];
#pragma unroll
        for (int j = 0; j < 8; ++j) { a0[j] = a0n[j]; a1[j] = a1n[j]; gs[j] = gsn[j]; }
        { const int rn_ = row + NGW < NROW ? row + NGW : row;
#pragma unroll
            for (int j = 0; j < 8; ++j) { const size_t off = (size_t)rn_ * DM + 4 * F.lane + 256 * j; a0n[j] = *(const u32x2*)(O0 + off); a1n[j] = *(const u32x2*)(O1 + off); gsn[j] = *(const u32x2*)(Gs + off); } }
#pragma unroll
        for (int j = 0; j < 8; ++j) { const size_t off = (size_t)row * DM + 4 * F.lane + 256 * j;
            const f32x4 o = (f32x4){bf2f(a0[j].x & 0xffffu), bf2f(a0[j].x >> 16), bf2f(a0[j].y & 0xffffu), bf2f(a0[j].y >> 16)} + (f32x4){bf2f(a1[j].x & 0xffffu), bf2f(a1[j].x >> 16), bf2f(a1[j].y & 0xffffu), bf2f(a1[j].y >> 16)};
            float s = (o[0] * o[0] + o[1] * o[1]) + (o[2] * o[2] + o[3] * o[3]);
#pragma unroll
            for (int m = 1; m < 32; m <<= 1) s += __shfl_xor(s, m);
            const float rs = rsqrtf(s * (1.f / 128.f) + NORM_EPS);
            const float y0 = o[0] * rs * g[0] * bf2f(gs[j].x & 0xffffu), y1 = o[1] * rs * g[1] * bf2f(gs[j].x >> 16), y2 = o[2] * rs * g[2] * bf2f(gs[j].y & 0xffffu), y3 = o[3] * rs * g[3] * bf2f(gs[j].y >> 16);
            u32x2 w; w.x = cvt_pk_bf16(y0, y1); w.y = cvt_pk_bf16(y2, y3); *(u32x2*)(Y + off) = w; }
    }
}
__device__ __forceinline__ void diff_combine_phase(Frame& F, float lambda_init) {
    FRAME_OPAQUE(F);
    unsigned char* ws = F.ws; const float* lp = F.in[15]; const float* sub = F.in[16];
    const bf16_t* O0 = (const bf16_t*)(ws + SC_DO); const bf16_t* O1 = O0 + ACT_ELEMS; bf16_t* Y = (bf16_t*)(ws + WS_ACT);
    float d1 = lp[F.lane] * lp[128 + F.lane] + lp[64 + F.lane] * lp[128 + 64 + F.lane], d2 = lp[256 + F.lane] * lp[384 + F.lane] + lp[256 + 64 + F.lane] * lp[384 + 64 + F.lane];
    d1 = wave_sum(d1); d2 = wave_sum(d2);
    const float lam = expf(d1) - expf(d2) + lambda_init, osc = 1.f - lambda_init;
    const int gw = F.bx * NWAVES + F.wave, NGW = F.G * NWAVES;
    const f32x4 g = *(const f32x4*)(sub + 4 * F.lane);
    u32x2 a0n[8], a1n[8];
    if (gw < NBATCH * SEQ) { const int row = (gw >> 11) * TPB + CTXL + (gw & 2047);
#pragma unroll
        for (int j = 0; j < 8; ++j) { const size_t off = (size_t)row * DM + 4 * F.lane + 256 * j; a0n[j] = *(const u32x2*)(O0 + off); a1n[j] = *(const u32x2*)(O1 + off); } }
    for (int r = gw; r < NBATCH * SEQ; r += NGW) { const int row = (r >> 11) * TPB + CTXL + (r & 2047);
        u32x2 a0[8], a1[8];
#pragma unroll
        for (int j = 0; j < 8; ++j) { a0[j] = a0n[j]; a1[j] = a1n[j]; }
        { const int rn = r + NGW < NBATCH * SEQ ? r + NGW : r, rown = (rn >> 11) * TPB + CTXL + (rn & 2047);
#pragma unroll
            for (int j = 0; j < 8; ++j) { const size_t off = (size_t)rown * DM + 4 * F.lane + 256 * j; a0n[j] = *(const u32x2*)(O0 + off); a1n[j] = *(const u32x2*)(O1 + off); } }
#pragma unroll
        for (int j = 0; j < 8; ++j) { const size_t off = (size_t)row * DM + 4 * F.lane + 256 * j;
            const f32x4 o = (f32x4){bf2f(a0[j].x & 0xffffu), bf2f(a0[j].x >> 16), bf2f(a0[j].y & 0xffffu), bf2f(a0[j].y >> 16)} - (f32x4){bf2f(a1[j].x & 0xffffu), bf2f(a1[j].x >> 16), bf2f(a1[j].y & 0xffffu), bf2f(a1[j].y >> 16)} * lam;
            const float s = wave_sum((o[0] * o[0] + o[1] * o[1]) + (o[2] * o[2] + o[3] * o[3]));
            const float rs = rsqrtf(s * (1.f / 256.f) + NORM_EPS) * osc;
            u32x2 w; w.x = cvt_pk_bf16(o[0] * rs * g[0], o[1] * rs * g[1]); w.y = cvt_pk_bf16(o[2] * rs * g[2], o[3] * rs * g[3]); *(u32x2*)(Y + off) = w; }
    }
}

__global__ void __launch_bounds__(NTHR, 2) dit_fwd(Args args) {
    extern __shared__ __attribute__((aligned(16))) unsigned char lds_raw[];
    Frame F;
    F.lds = (LAS unsigned char*)lds_raw; F.ws = args.ws; F.in = args.in;
    F.tid = threadIdx.x; F.lane = F.tid & 63; F.wave = __builtin_amdgcn_readfirstlane(F.tid >> 6);
    F.G = gridDim.x; F.bx = blockIdx.x; F.vcu = (F.G % 8 == 0) ? (F.bx % 8) * (F.G / 8) + F.bx / 8 : F.bx;
    unsigned char* ws = args.ws;
    volatile LAS unsigned* MISC = (volatile LAS unsigned*)(F.lds + MISC_OFF);
    if (F.tid < 32) MISC[F.tid] = 0u;
    __syncthreads();
    XcdBarrier bar; bar.bar = (unsigned*)(ws + WS_CTL) + CW_BAR; bar.x = 0; bar.st = nullptr;
    if (!MK_PER_PHASE) bar = xcd_barrier_post((unsigned*)(ws + WS_CTL) + CW_BAR, MISC + 8);
    const int lo = args.ph_lo, hi = args.ph_hi;
    int pid = 0;
#ifndef PHMASK
#define PHMASK 0xFFFFF
#endif
#define EN(k) (((PHMASK) >> (k)) & 1)
#ifndef REPMASK
#define REPMASK 0
#endif
#define SITE(k) if (EN(k) && RUN) _Pragma("unroll 1") for (int rep_ = 0; rep_ < 1 + (((REPMASK) >> (k)) & 1); ++rep_, (rep_ < 1 + (((REPMASK) >> (k)) & 1)) ? xcd_barrier(bar) : (void)0)
#define RUN (lo <= pid && pid < hi)
#define SEAM do { if (!MK_PER_PHASE) { if (lo <= pid && pid + 1 < hi) xcd_barrier(bar); } ++pid; } while (0)
    using namespace pg8;
    const int G = F.G, c = F.bx;

    SITE(0) p0_prologue(F);
    SEAM;
    SITE(1) row_phase<0>(F, 0, false, true, nullptr, false);
    SEAM;

#pragma unroll 1
    for (int layer = 0; layer < DEPTH; ++layer) {
        const int mixer = layer % 3;
        const bool latonly = layer >= 2;
        const int nM = latonly ? 32 : 36;
        const bf16_t* WoT;
        if (mixer == 0) {
            const bool with_ctx = layer == 0;
            SITE(2) { SchedSeqDft S{(const char*)(ws + WS_CS), (const char*)(ws + SC_HT), (const char*)(ws + WS_CS256), (const char*)(ws + SC_HTC), with_ctx ? 1 : 0, G, c};
                EpiBf16<0> E{ws, SC_PQ, SC_PQC, 4096};
                gemm_phase<EpiBf16<0>, SchedSeqDft, true, true>(F.lds, 2048, 2048, S, E); }
            SEAM;
            SITE(3) { SchedChanDft S{(const char*)(ws + SC_PQ), (const char*)(ws + SC_PQC), (const char*)(ws + WS_CC), (const char*)(ws + WS_CC) + 512 * 512 * 2, with_ctx ? 1 : 0, G, c};
                EpiChan E{(bf16_t*)(ws + WS_ACT)};
                gemm_phase<EpiChan, SchedChanDft, true, true>(F.lds, 4096, 512, S, E); }
            SEAM;
            WoT = (const bf16_t*)(ws + WS_FWO) + (size_t)(layer / 3) * DM * DM;
        } else if (mixer == 1) {
            const bool defer_g = (G == 256);
            SITE(4) { SchedRows S{(const char*)(ws + WS_H), (const char*)(ws + WS_HWIN), 2048, 2048, 36, defer_g ? 35 : 40, 32, 0, G, c};
                EpiHgrn E{ws, (const float*)(ws + WS_LB)};
                gemm_phase<EpiHgrn, SchedRows, true, true>(F.lds, 2048, 2048, S, E); }
            SEAM;
            SITE(5) { if (defer_g && F.bx >= 128) { SchedRows S{(const char*)(ws + WS_H), (const char*)(ws + WS_HWIN) + (size_t)35 * 256 * 2048 * 2, 2048, 2048, 36, 5, 32, 0, 128, F.bx - 128, 35};
                    EpiHgrn E{ws, (const float*)(ws + WS_LB)};
                    gemm_phase<EpiHgrn, SchedRows, true, true>(F.lds, 2048, 2048, S, E); }
                for (int u = F.bx; u < 128; u += G) { const int b = u >> 5, h = (u >> 1) & 15, dir = u & 1;
                scan::scan_unit(F.lds, (const bf16_t*)(ws + SC_HQ), (const bf16_t*)(ws + SC_HK) + (size_t)dir * ACT_ELEMS, (const _Float16*)(ws + SC_HLF) + (size_t)dir * ACT_ELEMS,
                                (const bf16_t*)(ws + SC_HV), (bf16_t*)(ws + SC_HO) + (size_t)dir * ACT_ELEMS, b, h, dir); } }
            SEAM;
            SITE(6) hgrn_readout_phase(F);
            SEAM;
            WoT = (const bf16_t*)(ws + WS_HWO);
        } else {
            SITE(7) { SchedQkv S{(const char*)(ws + WS_H), (const char*)(ws + WS_DQKV), G, c};
                EpiQkv E{ws, (const float*)(ws + WS_ROPE), (const float*)(ws + WS_ROPE) + 2048 * 64};
                gemm_phase<EpiQkv, SchedQkv, true, true>(F.lds, 2048, 2048, S, E); }
            SEAM;
            SITE(8) {
                const float lambda_init = 0.8f - 0.6f * expf(-0.3f * (float)layer);
                const float* lp = F.in[15]; const float* sub = F.in[16];
                for (int u = F.vcu; u < 256; u += G) { const int qb = u & 7, h = (u >> 3) & 7, b = u >> 6;
                    const size_t qrow = (size_t)b * TPB + CTXL + qb * 256, krow = (size_t)b * TPB;
#pragma unroll 1
                    for (int mq = 0; mq < 4; ++mq) { const int m = mq >> 1, qh = mq & 1;
                        attn::attn_pair_body((const bf16_t*)(ws + SC_DQ) + (qrow + qh * 128) * DM + h * 256 + m * 128, (const bf16_t*)(ws + SC_DK) + krow * DM + h * 256 + m * 128,
                                             (const bf16_t*)(ws + SC_DV) + krow * DM + h * 256, (bf16_t*)(ws + SC_DO) + (size_t)m * ACT_ELEMS + (qrow + qh * 128) * DM + h * 256, TPB, (char*)lds_raw); }
                    VM_WAIT(); __syncthreads();
                    FRAME_OPAQUE(F);
                    float d1 = lp[F.lane] * lp[128 + F.lane] + lp[64 + F.lane] * lp[128 + 64 + F.lane], d2 = lp[256 + F.lane] * lp[384 + F.lane] + lp[256 + 64 + F.lane] * lp[384 + 64 + F.lane];
                    d1 = wave_sum(d1); d2 = wave_sum(d2);
                    const float lam = expf(d1) - expf(d2) + lambda_init, osc = 1.f - lambda_init;
                    const bf16_t* O0 = (const bf16_t*)(ws + SC_DO) + qrow * DM + h * 256; const bf16_t* O1 = O0 + ACT_ELEMS; bf16_t* Y = (bf16_t*)(ws + WS_ACT) + qrow * DM + h * 256;
                    const f32x4 g = *(const f32x4*)(sub + 4 * F.lane);
#pragma unroll 1
                    for (int r0 = F.wave; r0 < 256; r0 += 16 * NWAVES) {
                        u32x2 a0[16], a1[16];
#pragma unroll
                        for (int k = 0; k < 16; ++k) { const size_t off = (size_t)(r0 + k * NWAVES) * DM + 4 * F.lane; a0[k] = *(const u32x2*)(O0 + off); a1[k] = *(const u32x2*)(O1 + off); }
#pragma unroll
                        for (int k = 0; k < 16; ++k) { const size_t off = (size_t)(r0 + k * NWAVES) * DM + 4 * F.lane;
                            const f32x4 o = (f32x4){bf2f(a0[k].x & 0xffffu), bf2f(a0[k].x >> 16), bf2f(a0[k].y & 0xffffu), bf2f(a0[k].y >> 16)} - (f32x4){bf2f(a1[k].x & 0xffffu), bf2f(a1[k].x >> 16), bf2f(a1[k].y & 0xffffu), bf2f(a1[k].y >> 16)} * lam;
                            const float s = wave_sum((o[0] * o[0] + o[1] * o[1]) + (o[2] * o[2] + o[3] * o[3]));
                            const float rs = rsqrtf(s * (1.f / 256.f) + NORM_EPS) * osc;
                            u32x2 w; w.x = cvt_pk_bf16(o[0] * rs * g[0], o[1] * rs * g[1]); w.y = cvt_pk_bf16(o[2] * rs * g[2], o[3] * rs * g[3]); *(u32x2*)(Y + off) = w; } }
                    __syncthreads(); } }
            SEAM;
            WoT = (const bf16_t*)(ws + WS_DWO);
        }
        const bool splitk = !latonly && G == 256;
        SITE(10) { EpiF32 E{ws, WS_YO, WS_SLAB, SLAB_BYTES, 2048};
            if (splitk) { SchedRowsSK S{(const char*)(ws + WS_ACT), (const char*)WoT, 2048, 2048, 32, G, c}; gemm_phase<EpiF32, SchedRowsSK, true, true>(F.lds, 2048, 2048, S, E); }
            else { EpiF32 E2{ws, WS_YO, WS_YO, 0, 2048}; SchedRows S{(const char*)(ws + WS_ACT), (const char*)WoT, 2048, 2048, nM, 8, 32, latonly ? 1 : 0, G, c}; gemm_phase<EpiF32, SchedRows, true, true>(F.lds, 2048, 2048, S, E2); } }
        SEAM;
        SITE(11) row_phase<1>(F, layer, latonly, false, nullptr, splitk);
        SEAM;
        SITE(12) { SchedRows S{(const char*)(ws + WS_H), (const char*)(ws + WS_W1T) + (size_t)layer * DM * HID * 2, 2048, 2048, nM, 32, 32, latonly ? 1 : 0, G, c};
            EpiBf16<1> E{ws, SC_U, SC_U, HID};
            gemm_phase<EpiBf16<1>, SchedRows, true, true>(F.lds, 2048, 2048, S, E); }
        SEAM;
        SITE(13) { EpiF32 E{ws, WS_YO, WS_SLAB, SLAB_BYTES, 2048}; const char* W2 = (const char*)(ws + WS_W2T) + (size_t)layer * DM * HID * 2;
            if (splitk) { SchedRowsSK S{(const char*)(ws + SC_U), W2, HID, HID, 128, G, c}; gemm_phase<EpiF32, SchedRowsSK, true, true>(F.lds, HID, HID, S, E); }
            else { EpiF32 E2{ws, WS_YO, WS_YO, 0, 2048}; SchedRows S{(const char*)(ws + SC_U), W2, HID, HID, nM, 8, 128, latonly ? 1 : 0, G, c}; gemm_phase<EpiF32, SchedRows, true, true>(F.lds, HID, HID, S, E2); } }
        SEAM;
        SITE(14) row_phase<2>(F, layer, layer >= 2, layer == 2, layer == 3 ? args.out : nullptr, splitk);
        SEAM;
    }
#undef RUN
#undef SEAM
}

constexpr int N_PHASES = 2 + 7 + 8 + 7 + 7;
extern "C" void kernel_launch(void* const* d_in, const int* in_sizes, int n_in, void* d_out, int out_size, void* d_ws, size_t ws_size, hipStream_t stream) {
    static int grid = 0;
    if (grid == 0) {
        if (n_in != 18 || out_size != NBATCH * SEQ * DM || ws_size < WS_END) { fprintf(stderr, "kernel_launch: unexpected shapes (n_in %d out %d ws %zu)\n", n_in, out_size, ws_size); grid = -1; return; }
        int dev = 0, cus = 0, per_cu = 0;
        if (hipGetDevice(&dev) != hipSuccess || hipDeviceGetAttribute(&cus, hipDeviceAttributeMultiprocessorCount, dev) != hipSuccess) { grid = -1; return; }
        if (hipFuncSetAttribute((const void*)dit_fwd, hipFuncAttributeMaxDynamicSharedMemorySize, LDS_BYTES) != hipSuccess) { fprintf(stderr, "kernel_launch: hipFuncSetAttribute failed\n"); grid = -1; return; }
        if (hipOccupancyMaxActiveBlocksPerMultiprocessor(&per_cu, (const void*)dit_fwd, NTHR, LDS_BYTES) != hipSuccess || per_cu < 1) fprintf(stderr, "kernel_launch: occupancy query says %d\n", per_cu);
        (void)hipGetLastError();
        grid = cus;
    }
    if (grid < 0) return;
    (void)hipMemsetAsync((char*)d_ws + WS_CTL, 0, CTL_BYTES, stream);
    Args a{};
    for (int i = 0; i < 18; ++i) a.in[i] = (const float*)d_in[i];
    a.out = (float*)d_out; a.ws = (unsigned char*)d_ws;
#if MK_PER_PHASE
    for (int p = 0; p < N_PHASES; ++p) { a.ph_lo = p; a.ph_hi = p + 1; hipLaunchKernelGGL(dit_fwd, dim3(grid), dim3(NTHR), LDS_BYTES, stream, a); }
#else
    a.ph_lo = 0; a.ph_hi = N_PHASES; hipLaunchKernelGGL(dit_fwd, dim3(grid), dim3(NTHR), LDS_BYTES, stream, a);
#endif
    const hipError_t le = hipPeekAtLastError();
    if (le != hipSuccess) fprintf(stderr, "kernel_launch: launch failed: %s\n", hipGetErrorName(le));
}
```
